# Optimizing an MI355X kernel written in HIP

```python
import jax, jax.numpy as jnp
from jax import lax
import numpy as np

D_MODEL = 1024
BATCH = 16
SEQ = 256
DEPTH = 1
DEC_BATCH = 2
DEC_SEQ = 4096
PAST_LEN = 256

GRID_W = 64
NH_M = 4
DH_M = D_MODEL // NH_M
D_MLSTM = NH_M * DH_M
CHUNK = 64
N_Q = 8
N_KV = 2
G_Q = N_Q // N_KV
DH_A = 128
D_ATT_Q = N_Q * DH_A
D_ATT_KV = N_KV * DH_A
N_FREQ = DH_A // 4
ROPE_BASE = 10000.0
D_FF = 4 * D_MODEL
Q_BLOCK = 128
EPS = 1e-6
ALPHA = (2 * DEPTH) ** 0.25
BETA = (8 * DEPTH) ** -0.25
SPLITS = (D_MLSTM, D_MLSTM, D_MLSTM, D_MLSTM, 4 * NH_M, D_ATT_Q, D_ATT_KV, D_ATT_KV, D_MODEL, D_MODEL)
D_IN = sum(SPLITS)

kernel_name = 'hybrid_mlstm_gqa_dit_step'


def _split(x, sizes):
    idx = np.cumsum(sizes)[:-1].tolist()
    return jnp.split(x, idx, axis=-1)


def layer_norm(x, g, b):
    xf = x.astype(jnp.float32)
    mu = jnp.mean(xf, -1, keepdims=True)
    var = jnp.mean(jnp.square(xf - mu), -1, keepdims=True)
    return ((xf - mu) * lax.rsqrt(var + EPS)).astype(x.dtype) * g + b


def rms_norm(x, g):
    xf = x.astype(jnp.float32)
    return (xf * lax.rsqrt(jnp.mean(jnp.square(xf), -1, keepdims=True) + EPS)).astype(x.dtype) * g


def axial_rope_tables(n_tokens):
    rows = n_tokens // GRID_W
    row = jnp.repeat(jnp.arange(rows), GRID_W)
    col = jnp.tile(jnp.arange(GRID_W), rows)
    inv = ROPE_BASE ** (-jnp.arange(N_FREQ, dtype=jnp.float32) / N_FREQ)
    ang = jnp.stack([row, col], -1).astype(jnp.float32)[..., None] * inv
    ang = jnp.broadcast_to(ang[:, :, None, :], (n_tokens, 2, 2, N_FREQ))
    return jnp.cos(ang), jnp.sin(ang)


def apply_rope(x, cos, sin):
    xs = x.reshape(*x.shape[:-1], 2, 2, N_FREQ)
    rot = jnp.concatenate([-xs[..., 1:, :], xs[..., :1, :]], axis=-2)
    out = xs * cos[None, :, None] + rot * sin[None, :, None]
    return out.reshape(x.shape).astype(x.dtype)


def block_attention(q, k, v):
    B, T = q.shape[:2]
    nb = T // Q_BLOCK
    qb = jnp.moveaxis(q.reshape(B, nb, Q_BLOCK, N_KV, G_Q, DH_A), 1, 0)
    scale = DH_A ** -0.5

    def one_block(qblk):
        s = jnp.einsum('bqhgd,bkhd->bhgqk', qblk, k).astype(jnp.float32) * scale
        p = jax.nn.softmax(s, axis=-1).astype(v.dtype)
        return jnp.einsum('bhgqk,bkhd->bqhgd', p, v)

    o = lax.map(one_block, qb)
    return jnp.moveaxis(o, 0, 1).reshape(B, T, D_ATT_Q)


def mlstm_chunked(q, k, v, ig, lf, C0, n0, m0):
    B, H, T, _ = q.shape
    nc = T // CHUNK

    def to_chunks(a):
        return jnp.moveaxis(a.reshape(B, H, nc, CHUNK, *a.shape[3:]), 2, 0)

    causal = jnp.tril(jnp.ones((CHUNK, CHUNK), bool))

    def step(carry, xs):
        C, n, m = carry
        qc, kc, vc, ic, fc = xs
        b = jnp.cumsum(fc, -1)
        dmat = jnp.where(causal, b[..., :, None] - b[..., None, :] + ic[..., None, :], -jnp.inf)
        g_inter = b + m[..., None]
        m_row = jnp.maximum(g_inter, jnp.max(dmat, -1))
        s = jnp.einsum('bhid,bhjd->bhij', qc, kc) * jnp.exp(dmat - m_row[..., None])
        w_inter = jnp.exp(g_inter - m_row)
        num = w_inter[..., None] * jnp.einsum('bhid,bhde->bhie', qc, C) + jnp.einsum('bhij,bhje->bhie', s, vc)
        den = w_inter * jnp.einsum('bhid,bhd->bhi', qc, n) + jnp.sum(s, -1)
        h = num / jnp.maximum(jnp.abs(den), jnp.exp(-m_row))[..., None]
        b_last = b[..., -1]
        w_end = b_last[..., None] - b + ic
        m_new = jnp.maximum(b_last + m, jnp.max(w_end, -1))
        decay = jnp.exp(b_last + m - m_new)
        wk = jnp.exp(w_end - m_new[..., None])[..., None] * kc
        C_new = decay[..., None, None] * C + jnp.einsum('bhjd,bhje->bhde', wk, vc)
        n_new = decay[..., None] * n + jnp.sum(wk, -2)
        return (C_new, n_new, m_new), h

    carry0 = (C0.astype(jnp.float32), n0.astype(jnp.float32), m0.astype(jnp.float32))
    (C, n, m), hs = lax.scan(step, carry0, (to_chunks(q), to_chunks(k), to_chunks(v), to_chunks(ig), to_chunks(lf)))
    h = jnp.moveaxis(hs, 0, 2).reshape(B, H, T, -1)
    return h, C, n, m


def mlstm_bidir(q, k, v, gates, C0, n0, m0):
    B, T = q.shape[:2]
    tr = lambda a: jnp.transpose(a.astype(jnp.float32), (0, 2, 1, 3))
    qf, kf, vf = tr(q), tr(k) * (DH_M ** -0.5), tr(v)
    g4 = jnp.transpose(gates.astype(jnp.float32).reshape(B, T, 4, NH_M), (2, 0, 3, 1))
    ig_f, lf_f, ig_b, lf_b = g4[0], jax.nn.log_sigmoid(g4[1]), g4[2], jax.nn.log_sigmoid(g4[3])
    hf, Cf, nf, mf = mlstm_chunked(qf, kf, vf, ig_f, lf_f, C0[:, 0], n0[:, 0], m0[:, 0])
    flip = lambda a: jnp.flip(a, axis=2)
    hb, Cb, nb, mb = mlstm_chunked(flip(qf), flip(kf), flip(vf), flip(ig_b), flip(lf_b), C0[:, 1], n0[:, 1], m0[:, 1])
    h = jnp.transpose(hf + flip(hb), (0, 2, 1, 3)).astype(q.dtype)
    return h, jnp.stack([Cf, Cb], 1), jnp.stack([nf, nb], 1), jnp.stack([mf, mb], 1)


def mixer(h, w_in, b_gates, mlstm_norm_g, q_norm_g, k_norm_g, w_bm, w_ba, w_out, C0, n0, m0, ctx_kv, rope):
    B, T, _ = h.shape
    qm, km, vm, om, gates, qa, ka, va, gm, ga = _split(h @ w_in, SPLITS)
    shp_m = (B, T, NH_M, DH_M)
    hm, C, n, m = mlstm_bidir(qm.reshape(shp_m), km.reshape(shp_m), vm.reshape(shp_m), gates + b_gates, C0, n0, m0)
    hm = rms_norm(hm, mlstm_norm_g.reshape(NH_M, DH_M)).reshape(B, T, D_MLSTM) * jax.nn.sigmoid(om)
    qa = rms_norm(qa.reshape(B, T, N_Q, DH_A), q_norm_g)
    ka = rms_norm(ka.reshape(B, T, N_KV, DH_A), k_norm_g)
    va = va.reshape(B, T, N_KV, DH_A)
    if rope is None:
        keys, vals = ka, va
    else:
        qa = apply_rope(qa, *rope)
        ka = apply_rope(ka, *rope)
        keys = jnp.concatenate([ka, ctx_kv[0].astype(ka.dtype)], axis=1)
        vals = jnp.concatenate([va, ctx_kv[1].astype(va.dtype)], axis=1)
    ha = block_attention(qa.reshape(B, T, N_KV, G_Q, DH_A), keys, vals)
    merged = jax.nn.sigmoid(gm) * (hm @ w_bm) + jax.nn.sigmoid(ga) * (ha @ w_ba)
    return merged @ w_out, (ka, va), (C, n, m)


def trunk_layer(x, mod, w_in, b_gates, mlstm_norm_g, q_norm_g, k_norm_g, w_bm, w_ba, w_out,
                ln1_g, ln1_b, w_up, w_down, ln2_g, ln2_b, C0, n0, m0, ctx_kv, rope):
    sh1, sc1, g1, sh2, sc2, g2 = jnp.split(mod[:, None, :], 6, axis=-1)
    h = x * (1 + sc1) + sh1
    mix, kv, st = mixer(h, w_in, b_gates, mlstm_norm_g, q_norm_g, k_norm_g, w_bm, w_ba, w_out, C0, n0, m0, ctx_kv, rope)
    x = layer_norm(ALPHA * x + g1 * mix, ln1_g, ln1_b)
    h = x * (1 + sc2) + sh2
    ff = jnp.square(jax.nn.relu(h @ w_up)) @ w_down
    x = layer_norm(ALPHA * x + g2 * ff, ln2_g, ln2_b)
    return x, kv, st


def setup_inputs(seed: int = 0) -> dict:
    key = jax.random.key(seed)
    ks = jax.random.split(key, 26)
    nrm = lambda k, shape, s: jax.random.normal(k, shape, jnp.float32) * s
    col_scale = jnp.asarray(np.concatenate(
        [np.full(s, BETA if i in (2, 7) else 1.0, np.float32) for i, s in enumerate(SPLITS)]))
    gate_offset = jnp.repeat(jnp.array([0.0, 3.0, 0.0, 3.0], jnp.float32), NH_M)
    return {
        'x_prompt': nrm(ks[0], (BATCH, SEQ, D_MODEL), 1.0),
        'x_sample': nrm(ks[1], (DEC_BATCH, DEC_SEQ, D_MODEL), 1.0),
        'cache_k': nrm(ks[2], (DEC_BATCH, DEPTH, PAST_LEN, N_KV, DH_A), 1.0),
        'cache_v': nrm(ks[3], (DEC_BATCH, DEPTH, PAST_LEN, N_KV, DH_A), 0.5),
        'state_C': nrm(ks[4], (DEC_BATCH, DEPTH, 2, NH_M, DH_M, DH_M), 0.05),
        'state_n': nrm(ks[5], (DEC_BATCH, DEPTH, 2, NH_M, DH_M), 0.05),
        'state_m': nrm(ks[6], (DEC_BATCH, DEPTH, 2, NH_M), 0.5),
        'c': nrm(ks[7], (DEC_BATCH, D_MODEL), 1.0),
        'c_ctx': nrm(ks[8], (D_MODEL,), 1.0),
        'w_mod': nrm(ks[9], (DEPTH, D_MODEL, 6 * D_MODEL), D_MODEL ** -0.5),
        'b_mod': nrm(ks[10], (DEPTH, 6 * D_MODEL), 0.02),
        'w_in': nrm(ks[11], (DEPTH, D_MODEL, D_IN), D_MODEL ** -0.5) * col_scale,
        'b_gates': nrm(ks[12], (DEPTH, 4 * NH_M), 0.1) + gate_offset,
        'mlstm_norm_g': 1.0 + nrm(ks[13], (DEPTH, D_MLSTM), 0.02),
        'q_norm_g': 1.0 + nrm(ks[14], (DEPTH, DH_A), 0.02),
        'k_norm_g': 1.0 + nrm(ks[15], (DEPTH, DH_A), 0.02),
        'w_bm': nrm(ks[16], (DEPTH, D_MLSTM, D_MODEL), D_MLSTM ** -0.5),
        'w_ba': nrm(ks[17], (DEPTH, D_ATT_Q, D_MODEL), D_ATT_Q ** -0.5),
        'w_out': nrm(ks[18], (DEPTH, D_MODEL, D_MODEL), BETA * D_MODEL ** -0.5),
        'ln1_g': 1.0 + nrm(ks[19], (DEPTH, D_MODEL), 0.02),
        'ln1_b': nrm(ks[20], (DEPTH, D_MODEL), 0.02),
        'w_up': nrm(ks[21], (DEPTH, D_MODEL, D_FF), D_MODEL ** -0.5),
        'w_down': nrm(ks[22], (DEPTH, D_FF, D_MODEL), BETA * D_FF ** -0.5),
        'ln2_g': 1.0 + nrm(ks[23], (DEPTH, D_MODEL), 0.02),
        'ln2_b': nrm(ks[24], (DEPTH, D_MODEL), 0.02),
    }


def reference(x_prompt, x_sample, cache_k, cache_v, state_C, state_n, state_m, c, c_ctx,
              w_mod, b_mod, w_in, b_gates, mlstm_norm_g, q_norm_g, k_norm_g, w_bm, w_ba, w_out,
              ln1_g, ln1_b, w_up, w_down, ln2_g, ln2_b):
    B = x_prompt.shape[0]
    zC = jnp.zeros((B, 2, NH_M, DH_M, DH_M), jnp.float32)
    zn = jnp.zeros((B, 2, NH_M, DH_M), jnp.float32)
    zm = jnp.zeros((B, 2, NH_M), jnp.float32)
    rope = axial_rope_tables(x_sample.shape[1])
    xp, xs = x_prompt, x_sample
    ks_, vs_, Cs_, ns_, ms_ = [], [], [], [], []
    for l in range(DEPTH):
        lw = (w_in[l], b_gates[l], mlstm_norm_g[l], q_norm_g[l], k_norm_g[l], w_bm[l], w_ba[l], w_out[l],
              ln1_g[l], ln1_b[l], w_up[l], w_down[l], ln2_g[l], ln2_b[l])
        mod_ctx = jax.nn.silu(c_ctx)[None, :] @ w_mod[l] + b_mod[l]
        mod_lat = jax.nn.silu(c) @ w_mod[l] + b_mod[l]
        xp, (k_l, v_l), (C_l, n_l, m_l) = trunk_layer(xp, mod_ctx, *lw, zC, zn, zm, None, None)
        ks_.append(k_l); vs_.append(v_l); Cs_.append(C_l); ns_.append(n_l); ms_.append(m_l)
        xs, _, _ = trunk_layer(xs, mod_lat, *lw, state_C[:, l], state_n[:, l], state_m[:, l],
                               (cache_k[:, l], cache_v[:, l]), rope)
    return (xp, xs, jnp.stack(ks_, 1), jnp.stack(vs_, 1), jnp.stack(Cs_, 1), jnp.stack(ns_, 1), jnp.stack(ms_, 1))
```

```cpp
#include <hip/hip_runtime.h>
#include <cstdint>
#include <cstdio>

typedef unsigned short bf16_t;
typedef float f32x4 __attribute__((ext_vector_type(4)));

constexpr int DM = 1024, NCTX = 4096, NLAT = 8192, MTOK = NCTX + NLAT, DIN = 7696, DFF = 4096;
constexpr int TCTX = 256, TLAT = 4096, PAST = 256, NSEQ_CTX = 16, NSEQ_LAT = 2;
constexpr int KV_ROWS_LAT = TLAT + PAST;
constexpr int KV_ROWS = NCTX + NSEQ_LAT * KV_ROWS_LAT;
constexpr float EPS = 1e-6f;
constexpr float ALPHA = 1.189207115002721f;
constexpr int C_QM = 0, C_KM = 1024, C_VM = 2048, C_OM = 3072, C_GATES = 4096, C_QA = 4112, C_KA = 5136, C_VA = 5392, C_GM = 5648, C_GA = 6672;
constexpr size_t O_Y = 0, O_CK = (size_t)MTOK * DM, O_CV = O_CK + 1048576, O_SC = O_CV + 1048576, O_SN = O_SC + 8388608, O_SM = O_SN + 32768;
constexpr size_t MiB = 1u << 20;
constexpr size_t WS_MOD = 0, WS_GATES = 1 * MiB, WS_HB = 2 * MiB, WS_QM = 26 * MiB, WS_KM = 50 * MiB, WS_VM = 74 * MiB, WS_OM = 98 * MiB,
                 WS_QA = 122 * MiB, WS_KA = 146 * MiB, WS_VA = 153 * MiB, WS_GM = 160 * MiB, WS_GA = 184 * MiB, WS_TMP = 208 * MiB;

__device__ __forceinline__ bf16_t f2bf(float f) { unsigned u = __float_as_uint(f); u += 0x7fffu + ((u >> 16) & 1u); return (bf16_t)(u >> 16); }
__device__ __forceinline__ float bf2f(bf16_t b) { return __uint_as_float(((unsigned)b) << 16); }
__device__ __forceinline__ float sigmoidf_(float x) { return 1.f / (1.f + expf(-x)); }
__device__ __forceinline__ float wave_sum(float v) {
#pragma unroll
    for (int o = 1; o < 64; o <<= 1) v += __shfl_xor(v, o);
    return v;
}
__device__ __forceinline__ int mod_index(int row) { return row < NCTX ? 0 : 1 + ((row - NCTX) >> 12); }
__device__ __forceinline__ const float* xrow_ptr(const float* xp, const float* xs, int row) { return row < NCTX ? xp + (size_t)row * DM : xs + (size_t)(row - NCTX) * DM; }

__global__ void k_mod(const float* __restrict__ c, const float* __restrict__ c_ctx, const float* __restrict__ w_mod, const float* __restrict__ b_mod, float* __restrict__ mod) {
    const int idx = blockIdx.x * 256 + threadIdx.x; if (idx >= 3 * 6144) return;
    const int r = idx / 6144, n = idx % 6144;
    const float* cv = r == 0 ? c_ctx : c + (r - 1) * DM;
    float acc = 0.f;
    for (int k = 0; k < DM; ++k) { const float x = cv[k]; acc += (x * sigmoidf_(x)) * w_mod[(size_t)k * 6144 + n]; }
    mod[idx] = acc + b_mod[n];
}
__global__ void k_hgates(const float* __restrict__ xp, const float* __restrict__ xs, const float* __restrict__ mod, const float* __restrict__ w_in, const float* __restrict__ b_gates,
                         bf16_t* __restrict__ HB, float* __restrict__ gates) {
    const int row = blockIdx.x * 4 + (threadIdx.x >> 6), lane = threadIdx.x & 63;
    const float* x = xrow_ptr(xp, xs, row); const float* md = mod + mod_index(row) * 6144;
    float g[16];
#pragma unroll
    for (int i = 0; i < 16; ++i) g[i] = 0.f;
    for (int j = 0; j < 4; ++j) {
        const int c0 = j * 256 + lane * 4;
        float h[4];
#pragma unroll
        for (int e = 0; e < 4; ++e) { const int cc = c0 + e; h[e] = x[cc] * (1.f + md[1024 + cc]) + md[cc]; HB[(size_t)row * DM + cc] = f2bf(h[e]); }
#pragma unroll
        for (int e = 0; e < 4; ++e) { const float* w = w_in + (size_t)(c0 + e) * DIN + C_GATES;
#pragma unroll
            for (int i = 0; i < 16; ++i) g[i] += h[e] * w[i]; }
    }
#pragma unroll
    for (int i = 0; i < 16; ++i) { const float s = wave_sum(g[i]); if (lane == 0) gates[(size_t)row * 16 + i] = s + b_gates[i]; }
}
__global__ void k_cache(const float* __restrict__ ck, const float* __restrict__ cv, bf16_t* __restrict__ KA, bf16_t* __restrict__ VA) {
    const int idx = blockIdx.x * 256 + threadIdx.x; if (idx >= 2 * 256 * 256) return;
    const int b = idx >> 16, j = (idx >> 8) & 255, col = idx & 255;
    const size_t dst = (size_t)(NCTX + b * KV_ROWS_LAT + TLAT + j) * 256 + col;
    KA[dst] = f2bf(ck[idx]); VA[dst] = f2bf(cv[idx]);
}

template <class Epi>
__global__ void __launch_bounds__(256) k_gemm(const bf16_t* __restrict__ A, const float* __restrict__ B, int lda, int ldb, int boff, int K, Epi E) {
    __shared__ float As[16][65];
    __shared__ float Bs[16][64];
    const int tid = threadIdx.x, tx = tid & 15, ty = tid >> 4, m0 = blockIdx.y * 64, n0 = blockIdx.x * 64;
    float acc[4][4];
#pragma unroll
    for (int i = 0; i < 4; ++i)
#pragma unroll
        for (int j = 0; j < 4; ++j) acc[i][j] = 0.f;
    for (int k0 = 0; k0 < K; k0 += 16) {
        { const int r = tid >> 2, kq = (tid & 3) * 4; const bf16_t* ap = A + (size_t)(m0 + r) * lda + k0 + kq;
#pragma unroll
          for (int e = 0; e < 4; ++e) As[kq + e][r] = bf2f(ap[e]); }
        { const int kk = tid >> 4, n4 = (tid & 15) * 4; const float* bp = B + (size_t)(k0 + kk) * ldb + boff + n0 + n4;
#pragma unroll
          for (int e = 0; e < 4; ++e) Bs[kk][n4 + e] = bp[e]; }
        __syncthreads();
#pragma unroll
        for (int kk = 0; kk < 16; ++kk) {
            float a[4], b[4];
#pragma unroll
            for (int i = 0; i < 4; ++i) { a[i] = As[kk][ty * 4 + i]; b[i] = Bs[kk][tx * 4 + i]; }
#pragma unroll
            for (int i = 0; i < 4; ++i)
#pragma unroll
                for (int j = 0; j < 4; ++j) acc[i][j] += a[i] * b[j];
        }
        __syncthreads();
    }
#pragma unroll
    for (int i = 0; i < 4; ++i)
#pragma unroll
        for (int j = 0; j < 4; ++j) E(m0 + ty * 4 + i, n0 + tx * 4 + j, acc[i][j]);
}
struct EpiBf16Scale { bf16_t* O; int ldo; float s; __device__ void operator()(int m, int n, float v) const { O[(size_t)m * ldo + n] = f2bf(v * s); } };
struct EpiBf16Sig   { bf16_t* O; int ldo; int pad; __device__ void operator()(int m, int n, float v) const { O[(size_t)m * ldo + n] = f2bf(sigmoidf_(v)); } };
struct EpiF32       { float* O; int ldo; int pad; __device__ void operator()(int m, int n, float v) const { O[(size_t)m * ldo + n] = v; } };
struct EpiVA { bf16_t* VA; float* cv_out;
    __device__ void operator()(int m, int n, float v) const {
        const int kvrow = m < NCTX ? m : NCTX + ((m - NCTX) >> 12) * KV_ROWS_LAT + ((m - NCTX) & 4095);
        VA[(size_t)kvrow * 256 + n] = f2bf(v); if (m < NCTX) cv_out[(size_t)m * 256 + n] = v; } };
struct EpiMerge { const float* Y1; const bf16_t* GM; const bf16_t* GA; bf16_t* O;
    __device__ void operator()(int m, int n, float v) const { const size_t i = (size_t)m * DM + n; O[i] = f2bf(bf2f(GM[i]) * Y1[i] + bf2f(GA[i]) * v); } };
struct EpiResidX { const float* xp; const float* xs; const float* mod; float* O; int goff; int pad;
    __device__ void operator()(int m, int n, float v) const { const float* x = xrow_ptr(xp, xs, m); O[(size_t)m * DM + n] = ALPHA * x[n] + mod[mod_index(m) * 6144 + goff + n] * v; } };
struct EpiResidInplace { const float* mod; float* O; int goff; int pad;
    __device__ void operator()(int m, int n, float v) const { const size_t i = (size_t)m * DM + n; O[i] = ALPHA * O[i] + mod[mod_index(m) * 6144 + goff + n] * v; } };
struct EpiRelu2 { bf16_t* O; __device__ void operator()(int m, int n, float v) const { const float r = v > 0.f ? v : 0.f; O[(size_t)m * DFF + n] = f2bf(r * r); } };

__global__ void k_qk_post(const float* __restrict__ T, const float* __restrict__ gain, bf16_t* __restrict__ O, float* __restrict__ ck_out, int nheads, int is_k) {
    const int gw = blockIdx.x * 4 + (threadIdx.x >> 6), lane = threadIdx.x & 63;
    const int row = gw / nheads, head = gw % nheads; if (row >= MTOK) return;
    const float* t = T + (size_t)row * (nheads * 128) + head * 128;
    const int axis = lane >> 5, f = lane & 31, d0 = axis * 64 + f, d1 = d0 + 32;
    float x0 = t[d0], x1 = t[d1];
    const float ss = wave_sum(x0 * x0 + x1 * x1);
    const float r = 1.f / sqrtf(ss * (1.f / 128.f) + EPS);
    x0 = x0 * r * gain[d0]; x1 = x1 * r * gain[d1];
    size_t orow;
    if (row < NCTX) {
        orow = row;
        if (is_k) { ck_out[(size_t)row * 256 + head * 128 + d0] = x0; ck_out[(size_t)row * 256 + head * 128 + d1] = x1; }
    } else {
        const int tt = (row - NCTX) & 4095, b = (row - NCTX) >> 12;
        const float pos = (float)(axis == 0 ? (tt >> 6) : (tt & 63));
        const float inv = powf(10000.f, -(float)f / 32.f);
        const float ang = pos * inv, cs = cosf(ang), sn = sinf(ang);
        const float y0 = x0 * cs - x1 * sn, y1 = x1 * cs + x0 * sn; x0 = y0; x1 = y1;
        orow = is_k ? (size_t)(NCTX + b * KV_ROWS_LAT + tt) : (size_t)row;
    }
    O[orow * (nheads * 128) + head * 128 + d0] = f2bf(x0); O[orow * (nheads * 128) + head * 128 + d1] = f2bf(x1);
}

__global__ void __launch_bounds__(256) k_mlstm(const bf16_t* __restrict__ QM, const bf16_t* __restrict__ KM, const bf16_t* __restrict__ VM, const float* __restrict__ gates,
                                                const float* __restrict__ sC, const float* __restrict__ sN, const float* __restrict__ sM,
                                                float* __restrict__ Hf, float* __restrict__ Hb, float* __restrict__ oC, float* __restrict__ oN, float* __restrict__ oM) {
    __shared__ float sq[256], sk[256], sv[32], red[8][33], redd[8];
    const int c = blockIdx.x >> 3, es = blockIdx.x & 7, tid = threadIdx.x, dg = tid >> 5, e = tid & 31;
    int T, row0, h, dir, b; bool ctx = c < 128;
    if (ctx) { b = c >> 3; h = (c >> 1) & 3; dir = c & 1; T = TCTX; row0 = b * TCTX; }
    else { const int cl = c - 128; b = cl >> 3; h = (cl >> 1) & 3; dir = cl & 1; T = TLAT; row0 = NCTX + b * TLAT; }
    float C[32], n[32], m = 0.f;
    if (ctx) {
#pragma unroll
        for (int i = 0; i < 32; ++i) { C[i] = 0.f; n[i] = 0.f; }
    } else {
        const size_t sb = (size_t)((b * 2 + dir) * 4 + h);
#pragma unroll
        for (int i = 0; i < 32; ++i) { const int d = dg * 32 + i; C[i] = sC[sb * 65536 + (size_t)d * 256 + es * 32 + e]; n[i] = sN[sb * 256 + d]; }
        m = sM[sb];
    }
    float* Hout = dir ? Hb : Hf;
    for (int s = 0; s < T; ++s) {
        const int t = dir ? T - 1 - s : s; const size_t row = (size_t)row0 + t;
        sq[tid] = bf2f(QM[row * DM + h * 256 + tid]); sk[tid] = bf2f(KM[row * DM + h * 256 + tid]);
        if (tid < 32) sv[tid] = bf2f(VM[row * DM + h * 256 + es * 32 + tid]);
        const float ig = gates[row * 16 + dir * 8 + h], fp = gates[row * 16 + dir * 8 + 4 + h];
        const float lf = fminf(fp, 0.f) - log1pf(expf(-fabsf(fp)));
        const float mn = fmaxf(lf + m, ig), decay = expf(lf + m - mn), wi = expf(ig - mn);
        __syncthreads();
        const float ve = sv[e] * wi; float ph = 0.f, pd = 0.f;
#pragma unroll
        for (int i = 0; i < 32; ++i) { const int d = dg * 32 + i; const float kd = sk[d], qd = sq[d];
            C[i] = decay * C[i] + kd * ve; n[i] = decay * n[i] + wi * kd; ph += qd * C[i]; pd += qd * n[i]; }
        red[dg][e] = ph; if (e == 0) redd[dg] = pd;
        __syncthreads();
        if (tid < 32) { float hh = 0.f, dd = 0.f;
#pragma unroll
            for (int g = 0; g < 8; ++g) { hh += red[g][tid]; dd += redd[g]; }
            Hout[row * DM + h * 256 + es * 32 + tid] = hh / fmaxf(fabsf(dd), expf(-mn)); }
        m = mn;
        __syncthreads();
    }
    if (ctx) {
        const size_t sb = (size_t)((b * 2 + dir) * 4 + h);
#pragma unroll
        for (int i = 0; i < 32; ++i) { const int d = dg * 32 + i; oC[sb * 65536 + (size_t)d * 256 + es * 32 + e] = C[i]; if (es == 0 && e == 0) oN[sb * 256 + d] = n[i]; }
        if (es == 0 && tid == 0) oM[sb] = m;
    }
}
__global__ void k_mlstm_post(const float* __restrict__ Hf, const float* __restrict__ Hb, const bf16_t* __restrict__ OM, const float* __restrict__ g, bf16_t* __restrict__ HM) {
    const int gw = blockIdx.x * 4 + (threadIdx.x >> 6), lane = threadIdx.x & 63, row = gw >> 2, h = gw & 3;
    const size_t base = (size_t)row * DM + h * 256 + lane * 4;
    float v[4], ss = 0.f;
#pragma unroll
    for (int e = 0; e < 4; ++e) { v[e] = Hf[base + e] + Hb[base + e]; ss += v[e] * v[e]; }
    ss = wave_sum(ss); const float r = 1.f / sqrtf(ss * (1.f / 256.f) + EPS);
#pragma unroll
    for (int e = 0; e < 4; ++e) HM[base + e] = f2bf(v[e] * r * g[h * 256 + lane * 4 + e] * bf2f(OM[base + e]));
}

__global__ void __launch_bounds__(256) k_attn(const bf16_t* __restrict__ QA, const bf16_t* __restrict__ KA, const bf16_t* __restrict__ VA, bf16_t* __restrict__ HA) {
    __shared__ float sQ[16][128], sK[32][129], sV[32][128], sP[16][32];
    const int head = blockIdx.x & 7, qg = blockIdx.x >> 3, row0 = qg * 16, tid = threadIdx.x, qi = tid >> 4, kl = tid & 15, kvh = head >> 2;
    int kbase, nk;
    if (row0 < NCTX) { kbase = (row0 >> 8) * 256; nk = 256; } else { kbase = NCTX + ((row0 - NCTX) >> 12) * KV_ROWS_LAT; nk = KV_ROWS_LAT; }
    for (int i = tid; i < 16 * 128; i += 256) sQ[i >> 7][i & 127] = bf2f(QA[(size_t)(row0 + (i >> 7)) * DM + head * 128 + (i & 127)]) * 0.08838834764831845f;
    float m = -1e30f, l = 0.f, o[8];
#pragma unroll
    for (int i = 0; i < 8; ++i) o[i] = 0.f;
    for (int k0 = 0; k0 < nk; k0 += 32) {
        __syncthreads();
        for (int i = tid; i < 32 * 128; i += 256) { const size_t g = (size_t)(kbase + k0 + (i >> 7)) * 256 + kvh * 128 + (i & 127); sK[i >> 7][i & 127] = bf2f(KA[g]); sV[i >> 7][i & 127] = bf2f(VA[g]); }
        __syncthreads();
        float s[2], tm = -1e30f;
#pragma unroll
        for (int j = 0; j < 2; ++j) { const int key = kl + 16 * j; float a = 0.f;
            for (int d = 0; d < 128; ++d) a += sQ[qi][d] * sK[key][d];
            s[j] = a; tm = fmaxf(tm, a); }
#pragma unroll
        for (int off = 1; off < 16; off <<= 1) tm = fmaxf(tm, __shfl_xor(tm, off));
        const float mn = fmaxf(m, tm), alpha = expf(m - mn); float ps = 0.f;
#pragma unroll
        for (int j = 0; j < 2; ++j) { const float p = expf(s[j] - mn); sP[qi][kl + 16 * j] = p; ps += p; }
#pragma unroll
        for (int off = 1; off < 16; off <<= 1) ps += __shfl_xor(ps, off);
        l = l * alpha + ps; m = mn;
        __syncthreads();
#pragma unroll
        for (int i = 0; i < 8; ++i) o[i] *= alpha;
        for (int key = 0; key < 32; ++key) { const float p = sP[qi][key];
#pragma unroll
            for (int i = 0; i < 8; ++i) o[i] += p * sV[key][kl * 8 + i]; }
    }
    const float rl = 1.f / l;
#pragma unroll
    for (int i = 0; i < 8; ++i) HA[(size_t)(row0 + qi) * DM + head * 128 + kl * 8 + i] = f2bf(o[i] * rl);
}

__global__ void k_ln(float* __restrict__ V, const float* __restrict__ g, const float* __restrict__ bta, const float* __restrict__ mod, bf16_t* __restrict__ H2) {
    const int row = blockIdx.x * 4 + (threadIdx.x >> 6), lane = threadIdx.x & 63;
    float* v = V + (size_t)row * DM; float x[16], s = 0.f;
#pragma unroll
    for (int j = 0; j < 4; ++j)
#pragma unroll
        for (int e = 0; e < 4; ++e) { x[j * 4 + e] = v[j * 256 + lane * 4 + e]; s += x[j * 4 + e]; }
    const float mean = wave_sum(s) * (1.f / DM); float q = 0.f;
#pragma unroll
    for (int i = 0; i < 16; ++i) { x[i] -= mean; q += x[i] * x[i]; }
    const float rstd = 1.f / sqrtf(wave_sum(q) * (1.f / DM) + EPS);
    const float* md = mod + mod_index(row) * 6144;
#pragma unroll
    for (int j = 0; j < 4; ++j)
#pragma unroll
        for (int e = 0; e < 4; ++e) { const int c = j * 256 + lane * 4 + e; const float y = x[j * 4 + e] * rstd * g[c] + bta[c]; v[c] = y;
            if (H2) H2[(size_t)row * DM + c] = f2bf(y * (1.f + md[4096 + c]) + md[3072 + c]); }
}

template <class Epi> static void gemm(hipStream_t st, const bf16_t* A, int lda, const float* B, int ldb, int boff, int M, int N, int K, Epi E) {
    hipLaunchKernelGGL((k_gemm<Epi>), dim3(N / 64, M / 64), dim3(256), 0, st, A, B, lda, ldb, boff, K, E);
}
extern "C" void kernel_launch(void* const* d_in, const int* in_sizes, int n_in, void* d_out, int out_size, void* d_ws, size_t ws_size, hipStream_t stream) {
    const float* x_prompt = (const float*)d_in[0]; const float* x_sample = (const float*)d_in[1];
    const float* cache_k = (const float*)d_in[2]; const float* cache_v = (const float*)d_in[3];
    const float* state_C = (const float*)d_in[4]; const float* state_n = (const float*)d_in[5]; const float* state_m = (const float*)d_in[6];
    const float* c = (const float*)d_in[7]; const float* c_ctx = (const float*)d_in[8];
    const float* w_mod = (const float*)d_in[9]; const float* b_mod = (const float*)d_in[10]; const float* w_in = (const float*)d_in[11]; const float* b_gates = (const float*)d_in[12];
    const float* mlstm_g = (const float*)d_in[13]; const float* q_g = (const float*)d_in[14]; const float* k_g = (const float*)d_in[15];
    const float* w_bm = (const float*)d_in[16]; const float* w_ba = (const float*)d_in[17]; const float* w_out = (const float*)d_in[18];
    const float* ln1_g = (const float*)d_in[19]; const float* ln1_b = (const float*)d_in[20]; const float* w_up = (const float*)d_in[21]; const float* w_down = (const float*)d_in[22];
    const float* ln2_g = (const float*)d_in[23]; const float* ln2_b = (const float*)d_in[24];
    float* out = (float*)d_out; unsigned char* ws = (unsigned char*)d_ws;
    float* MOD = (float*)(ws + WS_MOD); float* GATES = (float*)(ws + WS_GATES);
    bf16_t* HB = (bf16_t*)(ws + WS_HB); bf16_t* QM = (bf16_t*)(ws + WS_QM); bf16_t* KM = (bf16_t*)(ws + WS_KM); bf16_t* VM = (bf16_t*)(ws + WS_VM); bf16_t* OM = (bf16_t*)(ws + WS_OM);
    bf16_t* QA = (bf16_t*)(ws + WS_QA); bf16_t* KA = (bf16_t*)(ws + WS_KA); bf16_t* VA = (bf16_t*)(ws + WS_VA); bf16_t* GM = (bf16_t*)(ws + WS_GM); bf16_t* GA = (bf16_t*)(ws + WS_GA);
    float* TMP = (float*)(ws + WS_TMP);
    float* Y = out + O_Y;

    hipLaunchKernelGGL(k_mod, dim3(3 * 6144 / 256), dim3(256), 0, stream, c, c_ctx, w_mod, b_mod, MOD);
    hipLaunchKernelGGL(k_cache, dim3(2 * 256 * 256 / 256), dim3(256), 0, stream, cache_k, cache_v, KA, VA);
    hipLaunchKernelGGL(k_hgates, dim3(MTOK / 4), dim3(256), 0, stream, x_prompt, x_sample, MOD, w_in, b_gates, HB, GATES);
    gemm(stream, HB, DM, w_in, DIN, C_QM, MTOK, 1024, DM, EpiBf16Scale{QM, DM, 1.f});
    gemm(stream, HB, DM, w_in, DIN, C_KM, MTOK, 1024, DM, EpiBf16Scale{KM, DM, 0.0625f});
    gemm(stream, HB, DM, w_in, DIN, C_VM, MTOK, 1024, DM, EpiBf16Scale{VM, DM, 1.f});
    gemm(stream, HB, DM, w_in, DIN, C_OM, MTOK, 1024, DM, EpiBf16Sig{OM, DM, 0});
    gemm(stream, HB, DM, w_in, DIN, C_GM, MTOK, 1024, DM, EpiBf16Sig{GM, DM, 0});
    gemm(stream, HB, DM, w_in, DIN, C_GA, MTOK, 1024, DM, EpiBf16Sig{GA, DM, 0});
    gemm(stream, HB, DM, w_in, DIN, C_VA, MTOK, 256, DM, EpiVA{VA, out + O_CV});
    gemm(stream, HB, DM, w_in, DIN, C_QA, MTOK, 1024, DM, EpiF32{TMP, 1024, 0});
    hipLaunchKernelGGL(k_qk_post, dim3(MTOK * 8 / 4), dim3(256), 0, stream, TMP, q_g, QA, (float*)nullptr, 8, 0);
    gemm(stream, HB, DM, w_in, DIN, C_KA, MTOK, 256, DM, EpiF32{TMP, 256, 0});
    hipLaunchKernelGGL(k_qk_post, dim3(MTOK * 2 / 4), dim3(256), 0, stream, TMP, k_g, KA, out + O_CK, 2, 1);
    bf16_t* HA = HB;
    hipLaunchKernelGGL(k_attn, dim3(MTOK / 16 * 8), dim3(256), 0, stream, QA, KA, VA, HA);
    float* Hf = TMP; float* Hbk = Y;
    hipLaunchKernelGGL(k_mlstm, dim3(144 * 8), dim3(256), 0, stream, QM, KM, VM, GATES, state_C, state_n, state_m, Hf, Hbk, out + O_SC, out + O_SN, out + O_SM);
    bf16_t* HM = QM;
    hipLaunchKernelGGL(k_mlstm_post, dim3(MTOK * 4 / 4), dim3(256), 0, stream, Hf, Hbk, OM, mlstm_g, HM);
    gemm(stream, HM, DM, w_bm, DM, 0, MTOK, DM, DM, EpiF32{TMP, DM, 0});
    bf16_t* MERGED = KM;
    gemm(stream, HA, DM, w_ba, DM, 0, MTOK, DM, DM, EpiMerge{TMP, GM, GA, MERGED});
    gemm(stream, MERGED, DM, w_out, DM, 0, MTOK, DM, DM, EpiResidX{x_prompt, x_sample, MOD, Y, 2048, 0});
    bf16_t* H2 = QA;
    hipLaunchKernelGGL(k_ln, dim3(MTOK / 4), dim3(256), 0, stream, Y, ln1_g, ln1_b, MOD, H2);
    bf16_t* FF = (bf16_t*)(ws + WS_QM);
    gemm(stream, H2, DM, w_up, DFF, 0, MTOK, DFF, DM, EpiRelu2{FF});
    gemm(stream, FF, DFF, w_down, DM, 0, MTOK, DM, DFF, EpiResidInplace{MOD, Y, 5120, 0});
    hipLaunchKernelGGL(k_ln, dim3(MTOK / 4), dim3(256), 0, stream, Y, ln2_g, ln2_b, MOD, (bf16_t*)nullptr);
}
```

```cpp
#include <hip/hip_runtime.h>
#include <cstdint>
#include <cstdio>

typedef unsigned short bf16_t;
typedef float f32x4 __attribute__((ext_vector_type(4)));

constexpr int DM = 1024, NCTX = 4096, NLAT = 8192, MTOK = NCTX + NLAT, DIN = 7696, DFF = 4096;
constexpr int TCTX = 256, TLAT = 4096, PAST = 256, NSEQ_CTX = 16, NSEQ_LAT = 2;
constexpr int KV_ROWS_LAT = TLAT + PAST;
constexpr int KV_ROWS = NCTX + NSEQ_LAT * KV_ROWS_LAT;
constexpr float EPS = 1e-6f;
constexpr float ALPHA = 1.189207115002721f;
constexpr int C_QM = 0, C_KM = 1024, C_VM = 2048, C_OM = 3072, C_GATES = 4096, C_QA = 4112, C_KA = 5136, C_VA = 5392, C_GM = 5648, C_GA = 6672;
constexpr size_t O_Y = 0, O_CK = (size_t)MTOK * DM, O_CV = O_CK + 1048576, O_SC = O_CV + 1048576, O_SN = O_SC + 8388608, O_SM = O_SN + 32768;
constexpr size_t MiB = 1u << 20;
constexpr size_t WS_MOD = 0, WS_CH = 128 * 1024, WS_UN = 256 * 1024, WS_NT = 512 * 1024, WS_GATES = 1 * MiB, WS_SC = 2 * MiB, WS_HB = 4 * MiB, WS_QM = 28 * MiB, WS_QA = 52 * MiB,
                 WS_KA = 76 * MiB, WS_VA = 83 * MiB, WS_KM = 90 * MiB, WS_OM = 114 * MiB, WS_VT = 138 * MiB, WS_KFT = 162 * MiB, WS_KBT = 186 * MiB,
                 WS_WIN = 210 * MiB, WS_WBM = 225 * MiB, WS_WBA = 227 * MiB, WS_WOUT = 229 * MiB, WS_WUP = 231 * MiB, WS_WDN = 239 * MiB;
constexpr int R_QM = 0, R_OM = 1024, R_QA = 2048, R_KA = 3072, R_VA = 3328, R_KM = 3584, R_VM = 4608, R_GM = 5632, R_GA = 6656;
constexpr int SC_A = 0, SC_M = 1, SC_WU = 2, SC_WI = 3, SC_FL = 4; constexpr size_t SC_STRIDE = (size_t)8 * MTOK;
constexpr int CH_ALPHA = 0, CH_BETA = 256, CH_BETAC = 512;

__device__ __forceinline__ bf16_t f2bf(float f) { unsigned u = __float_as_uint(f); u += 0x7fffu + ((u >> 16) & 1u); return (bf16_t)(u >> 16); }
__device__ __forceinline__ float bf2f(bf16_t b) { return __uint_as_float(((unsigned)b) << 16); }
__device__ __forceinline__ float sigmoidf_(float x) { return 1.f / (1.f + expf(-x)); }
__device__ __forceinline__ float wave_sum(float v) {
#pragma unroll
    for (int o = 1; o < 64; o <<= 1) v += __shfl_xor(v, o);
    return v;
}
__device__ __forceinline__ int mod_index(int row) { return row < NCTX ? 0 : 1 + ((row - NCTX) >> 12); }
__device__ __forceinline__ const float* xrow_ptr(const float* xp, const float* xs, int row) { return row < NCTX ? xp + (size_t)row * DM : xs + (size_t)(row - NCTX) * DM; }

__global__ void k_mod(const float* __restrict__ c, const float* __restrict__ c_ctx, const float* __restrict__ w_mod, const float* __restrict__ b_mod, float* __restrict__ mod) {
    const int idx = blockIdx.x * 256 + threadIdx.x; if (idx >= 3 * 6144) return;
    const int r = idx / 6144, n = idx % 6144;
    const float* cv = r == 0 ? c_ctx : c + (r - 1) * DM;
    float acc = 0.f;
    for (int k = 0; k < DM; ++k) { const float x = cv[k]; acc += (x * sigmoidf_(x)) * w_mod[(size_t)k * 6144 + n]; }
    mod[idx] = acc + b_mod[n];
}
__global__ void k_hgates(const float* __restrict__ xp, const float* __restrict__ xs, const float* __restrict__ mod, const float* __restrict__ w_in, const float* __restrict__ b_gates,
                         bf16_t* __restrict__ HB, float* __restrict__ gates) {
    const int row = blockIdx.x * 4 + (threadIdx.x >> 6), lane = threadIdx.x & 63;
    const float* x = xrow_ptr(xp, xs, row); const float* md = mod + mod_index(row) * 6144;
    float g[16];
#pragma unroll
    for (int i = 0; i < 16; ++i) g[i] = 0.f;
    for (int j = 0; j < 4; ++j) {
        const int c0 = j * 256 + lane * 4;
        float h[4];
#pragma unroll
        for (int e = 0; e < 4; ++e) { const int cc = c0 + e; h[e] = x[cc] * (1.f + md[1024 + cc]) + md[cc]; HB[(size_t)row * DM + cc] = f2bf(h[e]); }
#pragma unroll
        for (int e = 0; e < 4; ++e) { const float* w = w_in + (size_t)(c0 + e) * DIN + C_GATES;
#pragma unroll
            for (int i = 0; i < 16; ++i) g[i] += h[e] * w[i]; }
    }
#pragma unroll
    for (int i = 0; i < 16; ++i) { const float s = wave_sum(g[i]); if (lane == 0) gates[(size_t)row * 16 + i] = s + b_gates[i]; }
}
__global__ void k_cache(const float* __restrict__ ck, const float* __restrict__ cv, bf16_t* __restrict__ KA, bf16_t* __restrict__ VA) {
    const int idx = blockIdx.x * 256 + threadIdx.x; if (idx >= 2 * 256 * 256) return;
    const int b = idx >> 16, j = (idx >> 8) & 255, col = idx & 255;
    const size_t dst = (size_t)(NCTX + b * KV_ROWS_LAT + TLAT + j) * 256 + col;
    KA[dst] = f2bf(ck[idx]); VA[dst] = f2bf(cv[idx]);
}

template <class Epi>
__global__ void __launch_bounds__(256) k_gemm(const bf16_t* __restrict__ A, const float* __restrict__ B, int lda, int ldb, int boff, int K, Epi E) {
    __shared__ float As[16][65];
    __shared__ float Bs[16][64];
    const int tid = threadIdx.x, tx = tid & 15, ty = tid >> 4, m0 = blockIdx.y * 64, n0 = blockIdx.x * 64;
    float acc[4][4];
#pragma unroll
    for (int i = 0; i < 4; ++i)
#pragma unroll
        for (int j = 0; j < 4; ++j) acc[i][j] = 0.f;
    for (int k0 = 0; k0 < K; k0 += 16) {
        { const int r = tid >> 2, kq = (tid & 3) * 4; const bf16_t* ap = A + (size_t)(m0 + r) * lda + k0 + kq;
#pragma unroll
          for (int e = 0; e < 4; ++e) As[kq + e][r] = bf2f(ap[e]); }
        { const int kk = tid >> 4, n4 = (tid & 15) * 4; const float* bp = B + (size_t)(k0 + kk) * ldb + boff + n0 + n4;
#pragma unroll
          for (int e = 0; e < 4; ++e) Bs[kk][n4 + e] = bp[e]; }
        __syncthreads();
#pragma unroll
        for (int kk = 0; kk < 16; ++kk) {
            float a[4], b[4];
#pragma unroll
            for (int i = 0; i < 4; ++i) { a[i] = As[kk][ty * 4 + i]; b[i] = Bs[kk][tx * 4 + i]; }
#pragma unroll
            for (int i = 0; i < 4; ++i)
#pragma unroll
                for (int j = 0; j < 4; ++j) acc[i][j] += a[i] * b[j];
        }
        __syncthreads();
    }
#pragma unroll
    for (int i = 0; i < 4; ++i)
#pragma unroll
        for (int j = 0; j < 4; ++j) E(m0 + ty * 4 + i, n0 + tx * 4 + j, acc[i][j]);
}
struct EpiBf16Scale { bf16_t* O; int ldo; float s; __device__ void operator()(int m, int n, float v) const { O[(size_t)m * ldo + n] = f2bf(v * s); } };
struct EpiBf16Sig   { bf16_t* O; int ldo; int pad; __device__ void operator()(int m, int n, float v) const { O[(size_t)m * ldo + n] = f2bf(sigmoidf_(v)); } };
struct EpiF32       { float* O; int ldo; int pad; __device__ void operator()(int m, int n, float v) const { O[(size_t)m * ldo + n] = v; } };
struct EpiVA { bf16_t* VA; float* cv_out;
    __device__ void operator()(int m, int n, float v) const {
        const int kvrow = m < NCTX ? m : NCTX + ((m - NCTX) >> 12) * KV_ROWS_LAT + ((m - NCTX) & 4095);
        VA[(size_t)kvrow * 256 + n] = f2bf(v); if (m < NCTX) cv_out[(size_t)m * 256 + n] = v; } };
struct EpiMerge { const float* Y1; const bf16_t* GM; const bf16_t* GA; bf16_t* O;
    __device__ void operator()(int m, int n, float v) const { const size_t i = (size_t)m * DM + n; O[i] = f2bf(bf2f(GM[i]) * Y1[i] + bf2f(GA[i]) * v); } };
struct EpiResidX { const float* xp; const float* xs; const float* mod; float* O; int goff; int pad;
    __device__ void operator()(int m, int n, float v) const { const float* x = xrow_ptr(xp, xs, m); O[(size_t)m * DM + n] = ALPHA * x[n] + mod[mod_index(m) * 6144 + goff + n] * v; } };
struct EpiResidInplace { const float* mod; float* O; int goff; int pad;
    __device__ void operator()(int m, int n, float v) const { const size_t i = (size_t)m * DM + n; O[i] = ALPHA * O[i] + mod[mod_index(m) * 6144 + goff + n] * v; } };
struct EpiVTn { bf16_t* VT; __device__ void operator()(int m, int n, float v) const { VT[(size_t)n * MTOK + m] = f2bf(v); } };
struct EpiRelu2 { bf16_t* O; __device__ void operator()(int m, int n, float v) const { const float r = v > 0.f ? v : 0.f; O[(size_t)m * DFF + n] = f2bf(r * r); } };

__global__ void k_qk_post(const float* __restrict__ T, const float* __restrict__ gain, bf16_t* __restrict__ O, float* __restrict__ ck_out, int nheads, int is_k) {
    const int gw = blockIdx.x * 4 + (threadIdx.x >> 6), lane = threadIdx.x & 63;
    const int row = gw / nheads, head = gw % nheads; if (row >= MTOK) return;
    const float* t = T + (size_t)row * (nheads * 128) + head * 128;
    const int axis = lane >> 5, f = lane & 31, d0 = axis * 64 + f, d1 = d0 + 32;
    float x0 = t[d0], x1 = t[d1];
    const float ss = wave_sum(x0 * x0 + x1 * x1);
    const float r = 1.f / sqrtf(ss * (1.f / 128.f) + EPS);
    x0 = x0 * r * gain[d0]; x1 = x1 * r * gain[d1];
    size_t orow;
    if (row < NCTX) {
        orow = row;
        if (is_k) { ck_out[(size_t)row * 256 + head * 128 + d0] = x0; ck_out[(size_t)row * 256 + head * 128 + d1] = x1; }
    } else {
        const int tt = (row - NCTX) & 4095, b = (row - NCTX) >> 12;
        const float pos = (float)(axis == 0 ? (tt >> 6) : (tt & 63));
        const float inv = powf(10000.f, -(float)f / 32.f);
        const float ang = pos * inv, cs = cosf(ang), sn = sinf(ang);
        const float y0 = x0 * cs - x1 * sn, y1 = x1 * cs + x0 * sn; x0 = y0; x1 = y1;
        orow = is_k ? (size_t)(NCTX + b * KV_ROWS_LAT + tt) : (size_t)row;
    }
    O[orow * (nheads * 128) + head * 128 + d0] = f2bf(x0); O[orow * (nheads * 128) + head * 128 + d1] = f2bf(x1);
}

__global__ void __launch_bounds__(256) k_mlstm(const bf16_t* __restrict__ QM, const bf16_t* __restrict__ KM, const bf16_t* __restrict__ VT, const float* __restrict__ gates,
                                                const float* __restrict__ sC, const float* __restrict__ sN, const float* __restrict__ sM, float* __restrict__ Hsum, float* __restrict__ oC, float* __restrict__ oN, float* __restrict__ oM, int dirsel, int pad_) {
    __shared__ float sq[256], sk[256], sv[32], red[8][33], redd[8];
    const int cc = blockIdx.x >> 3, es = blockIdx.x & 7, tid = threadIdx.x, dg = tid >> 5, e = tid & 31, dir = dirsel;
    int T, row0, h, b; const bool ctx = cc < 64;
    if (ctx) { b = cc >> 2; h = cc & 3; T = TCTX; row0 = b * TCTX; }
    else { const int cl = cc - 64; b = cl >> 2; h = cl & 3; T = TLAT; row0 = NCTX + b * TLAT; }
    float C[32], n[32], m = 0.f;
    if (ctx) {
#pragma unroll
        for (int i = 0; i < 32; ++i) { C[i] = 0.f; n[i] = 0.f; }
    } else {
        const size_t sb = (size_t)((b * 2 + dir) * 4 + h);
#pragma unroll
        for (int i = 0; i < 32; ++i) { const int d = dg * 32 + i; C[i] = sC[sb * 65536 + (size_t)d * 256 + es * 32 + e]; n[i] = sN[sb * 256 + d]; }
        m = sM[sb];
    }
    for (int s = 0; s < T; ++s) {
        const int t = dir ? T - 1 - s : s; const size_t row = (size_t)row0 + t;
        sq[tid] = bf2f(QM[row * DM + h * 256 + tid]); sk[tid] = bf2f(KM[row * DM + h * 256 + tid]);
        if (tid < 32) sv[tid] = bf2f(VT[(size_t)(h * 256 + es * 32 + tid) * MTOK + row]);
        const float ig = gates[row * 16 + dir * 8 + h], fp = gates[row * 16 + dir * 8 + 4 + h];
        const float lf = fminf(fp, 0.f) - log1pf(expf(-fabsf(fp)));
        const float mn = fmaxf(lf + m, ig), decay = expf(lf + m - mn), wi = expf(ig - mn);
        __syncthreads();
        const float ve = sv[e] * wi; float ph = 0.f, pd = 0.f;
#pragma unroll
        for (int i = 0; i < 32; ++i) { const int d = dg * 32 + i; const float kd = sk[d], qd = sq[d];
            C[i] = decay * C[i] + kd * ve; n[i] = decay * n[i] + wi * kd; ph += qd * C[i]; pd += qd * n[i]; }
        red[dg][e] = ph; if (e == 0) redd[dg] = pd;
        __syncthreads();
        if (tid < 32) { float hh = 0.f, dd = 0.f;
#pragma unroll
            for (int g = 0; g < 8; ++g) { hh += red[g][tid]; dd += redd[g]; }
            const float val = hh / fmaxf(fabsf(dd), expf(-mn)); float* hp = Hsum + row * DM + h * 256 + es * 32 + tid;
            if (dirsel == 0) *hp = val; else *hp += val; }
        m = mn;
        __syncthreads();
    }
    if (ctx && oC) {
        const size_t sb = (size_t)((b * 2 + dir) * 4 + h);
#pragma unroll
        for (int i = 0; i < 32; ++i) { const int d = dg * 32 + i; oC[sb * 65536 + (size_t)d * 256 + es * 32 + e] = C[i]; if (es == 0 && e == 0) oN[sb * 256 + d] = n[i]; }
        if (es == 0 && tid == 0) oM[sb] = m;
    }
}
__global__ void k_mlstm_post(const float* __restrict__ Hs, const bf16_t* __restrict__ OM, const float* __restrict__ g, bf16_t* __restrict__ HM) {
    const int gw = blockIdx.x * 4 + (threadIdx.x >> 6), lane = threadIdx.x & 63, row = gw >> 2, h = gw & 3;
    const size_t base = (size_t)row * DM + h * 256 + lane * 4;
    float v[4], ss = 0.f;
#pragma unroll
    for (int e = 0; e < 4; ++e) { v[e] = Hs[base + e]; ss += v[e] * v[e]; }
    ss = wave_sum(ss); const float r = 1.f / sqrtf(ss * (1.f / 256.f) + EPS);
#pragma unroll
    for (int e = 0; e < 4; ++e) HM[base + e] = f2bf(v[e] * r * g[h * 256 + lane * 4 + e] * bf2f(OM[base + e]));
}

__global__ void __launch_bounds__(256) k_attn(const bf16_t* __restrict__ QA, const bf16_t* __restrict__ KA, const bf16_t* __restrict__ VA, bf16_t* __restrict__ HA) {
    __shared__ float sQ[16][128], sK[32][129], sV[32][128], sP[16][32];
    const int head = blockIdx.x & 7, qg = blockIdx.x >> 3, row0 = qg * 16, tid = threadIdx.x, qi = tid >> 4, kl = tid & 15, kvh = head >> 2;
    int kbase, nk;
    if (row0 < NCTX) { kbase = (row0 >> 8) * 256; nk = 256; } else { kbase = NCTX + ((row0 - NCTX) >> 12) * KV_ROWS_LAT; nk = KV_ROWS_LAT; }
    for (int i = tid; i < 16 * 128; i += 256) sQ[i >> 7][i & 127] = bf2f(QA[(size_t)(row0 + (i >> 7)) * DM + head * 128 + (i & 127)]) * 0.08838834764831845f;
    float m = -1e30f, l = 0.f, o[8];
#pragma unroll
    for (int i = 0; i < 8; ++i) o[i] = 0.f;
    for (int k0 = 0; k0 < nk; k0 += 32) {
        __syncthreads();
        for (int i = tid; i < 32 * 128; i += 256) { const size_t g = (size_t)(kbase + k0 + (i >> 7)) * 256 + kvh * 128 + (i & 127); sK[i >> 7][i & 127] = bf2f(KA[g]); sV[i >> 7][i & 127] = bf2f(VA[g]); }
        __syncthreads();
        float s[2], tm = -1e30f;
#pragma unroll
        for (int j = 0; j < 2; ++j) { const int key = kl + 16 * j; float a = 0.f;
            for (int d = 0; d < 128; ++d) a += sQ[qi][d] * sK[key][d];
            s[j] = a; tm = fmaxf(tm, a); }
#pragma unroll
        for (int off = 1; off < 16; off <<= 1) tm = fmaxf(tm, __shfl_xor(tm, off));
        const float mn = fmaxf(m, tm), alpha = expf(m - mn); float ps = 0.f;
#pragma unroll
        for (int j = 0; j < 2; ++j) { const float p = expf(s[j] - mn); sP[qi][kl + 16 * j] = p; ps += p; }
#pragma unroll
        for (int off = 1; off < 16; off <<= 1) ps += __shfl_xor(ps, off);
        l = l * alpha + ps; m = mn;
        __syncthreads();
#pragma unroll
        for (int i = 0; i < 8; ++i) o[i] *= alpha;
        for (int key = 0; key < 32; ++key) { const float p = sP[qi][key];
#pragma unroll
            for (int i = 0; i < 8; ++i) o[i] += p * sV[key][kl * 8 + i]; }
    }
    const float rl = 1.f / l;
#pragma unroll
    for (int i = 0; i < 8; ++i) HA[(size_t)(row0 + qi) * DM + head * 128 + kl * 8 + i] = f2bf(o[i] * rl);
}

__global__ void k_ln(float* __restrict__ V, const float* __restrict__ g, const float* __restrict__ bta, const float* __restrict__ mod, bf16_t* __restrict__ H2) {
    const int row = blockIdx.x * 4 + (threadIdx.x >> 6), lane = threadIdx.x & 63;
    float* v = V + (size_t)row * DM; float x[16], s = 0.f;
#pragma unroll
    for (int j = 0; j < 4; ++j)
#pragma unroll
        for (int e = 0; e < 4; ++e) { x[j * 4 + e] = v[j * 256 + lane * 4 + e]; s += x[j * 4 + e]; }
    const float mean = wave_sum(s) * (1.f / DM); float q = 0.f;
#pragma unroll
    for (int i = 0; i < 16; ++i) { x[i] -= mean; q += x[i] * x[i]; }
    const float rstd = 1.f / sqrtf(wave_sum(q) * (1.f / DM) + EPS);
    const float* md = mod + mod_index(row) * 6144;
#pragma unroll
    for (int j = 0; j < 4; ++j)
#pragma unroll
        for (int e = 0; e < 4; ++e) { const int c = j * 256 + lane * 4 + e; const float y = x[j * 4 + e] * rstd * g[c] + bta[c]; v[c] = y;
            if (H2) H2[(size_t)row * DM + c] = f2bf(y * (1.f + md[4096 + c]) + md[3072 + c]); }
}


namespace pg8 {
#define PG8_LAS __attribute__((address_space(3)))
typedef unsigned short bf16_t;
typedef short bf16x8 __attribute__((ext_vector_type(8)));
typedef float f32x4 __attribute__((ext_vector_type(4)));
typedef unsigned u32x4 __attribute__((ext_vector_type(4)));
constexpr int BM = 256, BK = 64, HALF = 128, HTB = HALF * BK * 2  , STAGE_BYTES = 8 * HTB, NXCD = 8, WGM = 8;

__host__ __device__ __forceinline__ int lds_byte(int r, int c) { const int st = (r >> 4) * 2 + (c >> 5), rr = r & 15, cc = c & 31, ob = rr * 64 + cc * 2; return st * 1024 + (ob ^ (((ob >> 9) & 1) << 5)); }
__host__ __device__ __forceinline__ void stage_rc(int b, int& R, int& C) { const int st = b / 1024, sb = b % 1024, swz = sb ^ (((sb >> 9) & 1) << 5); R = (st >> 1) * 16 + swz / 64; C = (st & 1) * 32 + (swz % 64) / 2; }
__host__ __device__ __forceinline__ int perm32(int rho) { const int n = rho >> 4, i = rho & 15; return 8 * (i >> 2) + 4 * n + (i & 3); }

struct Unit { int pm, pn; };
struct Gemm { const bf16_t* A; const bf16_t* Bt; int M, N, K, lda, ldb, pad; };

struct StaticOrder {
    int nM, nN, nwg, G, c; size_t ta, tb;
    __host__ __device__ void init(int M, int N, int G_, int c_, int lda, int ldb) { nM = M / BM; nN = N / BM; nwg = nM * nN; G = G_; c = c_; ta = (size_t)BM * lda * 2; tb = (size_t)BM * ldb * 2; }
    __device__ __forceinline__ size_t a_off(const Unit& u) const { return (size_t)u.pm * ta; }
    __device__ __forceinline__ size_t b_off(const Unit& u) const { return (size_t)u.pn * tb; }
    __host__ __device__ bool next(int i, Unit& u) const {
        const long L = (long)i * G + c; if (L >= nwg) return false;
        int wgid = (int)L; { const int q = nwg / NXCD, r = nwg % NXCD, xcd = wgid % NXCD, off = wgid / NXCD; wgid = (xcd < r ? xcd * (q + 1) : r * (q + 1) + (xcd - r) * q) + off; }
        const int nig = WGM * nN, gid = wgid / nig, fm = gid * WGM, gsz = (nM - fm) < WGM ? (nM - fm) : WGM;
        u.pm = fm + ((wgid % nig) % gsz); u.pn = (wgid % nig) / gsz; return true;
    }
    __device__ __forceinline__ void a_ready(const Unit&) const {}
    __device__ __forceinline__ void done(const Unit&) const {}
};


typedef unsigned u32x2 __attribute__((ext_vector_type(2)));
__device__ __forceinline__ float fsig(float x) { return __builtin_amdgcn_rcpf(1.f + __builtin_amdgcn_exp2f(-1.4426950408889634f * x)); }
typedef float f32x2_t __attribute__((ext_vector_type(2))); typedef __bf16 bf16x2_t __attribute__((ext_vector_type(2)));
__device__ __forceinline__ unsigned cvt_pk_bf16(float lo, float hi) { f32x2_t v = {lo, hi}; bf16x2_t b = __builtin_convertvector(v, bf16x2_t); return __builtin_bit_cast(unsigned, b); }
__device__ __forceinline__ f32x4 bf4_to_f32(u32x2 w) { return (f32x4){__uint_as_float(w.x << 16), __uint_as_float(w.x & 0xffff0000u), __uint_as_float(w.y << 16), __uint_as_float(w.y & 0xffff0000u)}; }
struct EpiProj {
    static constexpr bool PERM = true, AFTER_DRAIN = false;
    bf16_t *QM, *OM, *QA, *KA, *VA, *KM, *GM, *GA; float* cv_out; int pn0, pad;
    __device__ __forceinline__ void operator()(const f32x4 (&acc)[2][2][4][2], const Unit& u, int wr, int wc, int fr, int fq) const {
        const int pn = u.pn + pn0; bf16_t* base; int ld = 1024, colt, act = 0; float sc = 1.f; bool kv = false;
        if (pn < 4) { base = QM; colt = pn * 256; }
        else if (pn < 8) { base = OM; colt = (pn - 4) * 256; act = 1; }
        else if (pn < 12) { base = QA; colt = (pn - 8) * 256; }
        else if (pn == 12) { base = KA; colt = 0; ld = 256; kv = true; }
        else if (pn == 13) { base = VA; colt = 0; ld = 256; kv = true; }
        else if (pn < 18) { base = KM; colt = (pn - 14) * 256; sc = 0.0625f; }
        else if (pn < 22) { base = GM; colt = (pn - 18) * 256; act = 1; }
        else { base = GA; colt = (pn - 22) * 256; act = 1; }
        const int row0 = u.pm * BM + wr * 64 + fr, radd = (kv && u.pm >= 16) ? ((u.pm - 16) >> 4) * 256 : 0, col0 = colt + wc * 32 + 8 * fq;
        const bool cvo = (pn == 13 && u.pm < 16);
#pragma unroll
        for (int ai = 0; ai < 2; ++ai)
#pragma unroll
            for (int m = 0; m < 4; ++m) { const int r = row0 + ai * HALF + m * 16; bf16_t* rowp = base + (size_t)(r + radd) * ld + col0;
#pragma unroll
                for (int bj = 0; bj < 2; ++bj) { f32x4 v0 = acc[ai][bj][m][0] * sc, v1 = acc[ai][bj][m][1] * sc;
                    if (act) {
#pragma unroll
                        for (int e = 0; e < 4; ++e) { v0[e] = fsig(v0[e]); v1[e] = fsig(v1[e]); } }
                    u32x4 w; w.x = cvt_pk_bf16(v0[0], v0[1]); w.y = cvt_pk_bf16(v0[2], v0[3]); w.z = cvt_pk_bf16(v1[0], v1[1]); w.w = cvt_pk_bf16(v1[2], v1[3]);
                    *(u32x4*)(rowp + bj * HALF) = w;
                    if (cvo) { float* cp = cv_out + (size_t)r * 256 + col0 + bj * HALF; *(f32x4*)cp = v0; *(f32x4*)(cp + 4) = v1; } } }
    }
};
struct EpiKVT {
    static constexpr bool PERM = true, AFTER_DRAIN = false;
    bf16_t* KT; bf16_t* VT; const float* wU;
    __device__ __forceinline__ void operator()(const f32x4 (&acc)[2][2][4][2], const Unit& u, int wr, int wc, int fr, int fq) const {
        const int head = u.pm & 3, tok0 = u.pn * BM + wc * 32 + 8 * fq; const bool isk = u.pm < 4;
        f32x4 wf[2][2], wb[2][2];
        if (isk) {
#pragma unroll
            for (int bj = 0; bj < 2; ++bj)
#pragma unroll
                for (int n = 0; n < 2; ++n) { wf[bj][n] = *(const f32x4*)(wU + (size_t)head * MTOK + tok0 + bj * HALF + 4 * n) * 0.0625f; wb[bj][n] = *(const f32x4*)(wU + (size_t)(4 + head) * MTOK + tok0 + bj * HALF + 4 * n) * 0.0625f; } }
#pragma unroll
        for (int ai = 0; ai < 2; ++ai)
#pragma unroll
            for (int m = 0; m < 4; ++m) { const int fl = head * 256 + ai * HALF + wr * 64 + m * 16 + fr;
#pragma unroll
                for (int bj = 0; bj < 2; ++bj) { const size_t o = (size_t)fl * MTOK + tok0 + bj * HALF; const f32x4 a0 = acc[ai][bj][m][0], a1 = acc[ai][bj][m][1];
                    if (isk) { f32x4 v0 = a0 * wf[bj][0], v1 = a1 * wf[bj][1]; u32x4 w; w.x = cvt_pk_bf16(v0[0], v0[1]); w.y = cvt_pk_bf16(v0[2], v0[3]); w.z = cvt_pk_bf16(v1[0], v1[1]); w.w = cvt_pk_bf16(v1[2], v1[3]); *(u32x4*)(KT + o) = w;
                        v0 = a0 * wb[bj][0]; v1 = a1 * wb[bj][1]; w.x = cvt_pk_bf16(v0[0], v0[1]); w.y = cvt_pk_bf16(v0[2], v0[3]); w.z = cvt_pk_bf16(v1[0], v1[1]); w.w = cvt_pk_bf16(v1[2], v1[3]); *(u32x4*)(KT + (size_t)1024 * MTOK + o) = w; }
                    else { u32x4 w; w.x = cvt_pk_bf16(a0[0], a0[1]); w.y = cvt_pk_bf16(a0[2], a0[3]); w.z = cvt_pk_bf16(a1[0], a1[1]); w.w = cvt_pk_bf16(a1[2], a1[3]); *(u32x4*)(VT + o) = w; } } }
    }
};
struct EpiSig2 {
    static constexpr bool PERM = true, AFTER_DRAIN = false; bf16_t* GM; bf16_t* GA;
    __device__ __forceinline__ void operator()(const f32x4 (&acc)[2][2][4][2], const Unit& u, int wr, int wc, int fr, int fq) const {
        bf16_t* base = u.pn < 4 ? GM : GA; const int row0 = u.pm * BM + wr * 64 + fr, col0 = (u.pn & 3) * 256 + wc * 32 + 8 * fq;
#pragma unroll
        for (int ai = 0; ai < 2; ++ai)
#pragma unroll
            for (int m = 0; m < 4; ++m) { bf16_t* rowp = base + (size_t)(row0 + ai * HALF + m * 16) * 1024 + col0;
#pragma unroll
                for (int bj = 0; bj < 2; ++bj) { f32x4 v0 = acc[ai][bj][m][0], v1 = acc[ai][bj][m][1];
#pragma unroll
                    for (int e = 0; e < 4; ++e) { v0[e] = fsig(v0[e]); v1[e] = fsig(v1[e]); }
                    u32x4 w; w.x = cvt_pk_bf16(v0[0], v0[1]); w.y = cvt_pk_bf16(v0[2], v0[3]); w.z = cvt_pk_bf16(v1[0], v1[1]); w.w = cvt_pk_bf16(v1[2], v1[3]);
                    *(u32x4*)(rowp + bj * HALF) = w; } }
    }
};
struct EpiUctx {
    static constexpr bool PERM = false, AFTER_DRAIN = false; float* oC; const float* betac;
    __device__ __forceinline__ void operator()(const f32x4 (&acc)[2][2][4][2], const Unit& u, int wr, int wc, int fr, int fq) const {
        const float beta = betac[u.pm]; float* ob = oC + (size_t)u.pm * 65536;
#pragma unroll
        for (int ai = 0; ai < 2; ++ai)
#pragma unroll
            for (int m = 0; m < 4; ++m) { float* rowp = ob + (size_t)(ai * HALF + wr * 64 + m * 16 + fr) * 256 + wc * 32 + 4 * fq;
#pragma unroll
                for (int bj = 0; bj < 2; ++bj)
#pragma unroll
                    for (int n = 0; n < 2; ++n) *(f32x4*)(rowp + bj * HALF + n * 16) = acc[ai][bj][m][n] * beta; }
    }
};
struct EpiUlat {
    static constexpr bool PERM = true, AFTER_DRAIN = false; bf16_t* UT;
    __device__ __forceinline__ void operator()(const f32x4 (&acc)[2][2][4][2], const Unit& u, int wr, int wc, int fr, int fq) const {
        const int id = u.pm, b = id / 120, rem = id % 120, dirh = rem / 15, ci = rem % 15, c = (dirh >> 2) ? ci + 1 : ci;
        bf16_t* ob = UT + (size_t)((b * 8 + dirh) * 16 + c) * 65536;
#pragma unroll
        for (int ai = 0; ai < 2; ++ai)
#pragma unroll
            for (int m = 0; m < 4; ++m) { bf16_t* rowp = ob + (size_t)(ai * HALF + wr * 64 + m * 16 + fr) * 256 + wc * 32 + 8 * fq;
#pragma unroll
                for (int bj = 0; bj < 2; ++bj) { const f32x4 v0 = acc[ai][bj][m][0], v1 = acc[ai][bj][m][1];
                    u32x4 w; w.x = cvt_pk_bf16(v0[0], v0[1]); w.y = cvt_pk_bf16(v0[2], v0[3]); w.z = cvt_pk_bf16(v1[0], v1[1]); w.w = cvt_pk_bf16(v1[2], v1[3]);
                    *(u32x4*)(rowp + bj * HALF) = w; } }
    }
};
struct UOrder {
    int G, c, mode, n;
    __device__ __forceinline__ void init(int G_, int c_, int mode_) { G = G_; c = c_; mode = mode_; n = mode_ ? 240 : 128; }
    __device__ __forceinline__ bool next(int i, Unit& u) const { const int L = i * G + c; if (L >= n) return false; u.pm = L; u.pn = L; return true; }
    __device__ __forceinline__ void offs(int id, size_t& ko, size_t& vo) const {
        int dirh, tok0;
        if (mode == 0) { dirh = id & 7; tok0 = (id >> 3) * 256; }
        else { const int b = id / 120, rem = id % 120, ci = rem % 15; dirh = rem / 15; tok0 = NCTX + b * TLAT + ((dirh >> 2) ? ci + 1 : ci) * 256; }
        const int dir = dirh >> 2, h = dirh & 3;
        ko = ((size_t)(dir * 1024 + h * 256) * MTOK + tok0) * 2; vo = ((size_t)(h * 256) * MTOK + tok0) * 2;
    }
    __device__ __forceinline__ size_t a_off(const Unit& u) const { size_t ko, vo; offs(u.pm, ko, vo); return mode == 0 ? ko : vo; }
    __device__ __forceinline__ size_t b_off(const Unit& u) const { size_t ko, vo; offs(u.pm, ko, vo); return mode == 0 ? vo : ko; }
    __device__ __forceinline__ void a_ready(const Unit&) const {}
    __device__ __forceinline__ void done(const Unit&) const {}
};
struct EpiStoreF32 {
    static constexpr bool PERM = false, AFTER_DRAIN = false; float* O; int ld, pad;
    __device__ __forceinline__ void operator()(const f32x4 (&acc)[2][2][4][2], const Unit& u, int wr, int wc, int fr, int fq) const {
        const int row0 = u.pm * BM + wr * 64 + fr, col0 = u.pn * BM + wc * 32 + 4 * fq;
#pragma unroll
        for (int ai = 0; ai < 2; ++ai)
#pragma unroll
            for (int m = 0; m < 4; ++m) { float* rowp = O + (size_t)(row0 + ai * HALF + m * 16) * ld + col0;
#pragma unroll
                for (int bj = 0; bj < 2; ++bj)
#pragma unroll
                    for (int n = 0; n < 2; ++n) *(f32x4*)(rowp + bj * HALF + n * 16) = acc[ai][bj][m][n]; }
    }
};
struct EpiMergeF {
    static constexpr bool PERM = false, AFTER_DRAIN = false; const float* Y1; const bf16_t* GM; const bf16_t* GA; bf16_t* O;
    __device__ __forceinline__ void operator()(const f32x4 (&acc)[2][2][4][2], const Unit& u, int wr, int wc, int fr, int fq) const {
        const int row0 = u.pm * BM + wr * 64 + fr, col0 = u.pn * BM + wc * 32 + 4 * fq;
#pragma unroll
        for (int ai = 0; ai < 2; ++ai)
#pragma unroll
            for (int m = 0; m < 4; ++m) { const size_t ro = (size_t)(row0 + ai * HALF + m * 16) * 1024 + col0;
#pragma unroll
                for (int bj = 0; bj < 2; ++bj)
#pragma unroll
                    for (int n = 0; n < 2; ++n) { const size_t i = ro + bj * HALF + n * 16;
                        const f32x4 y1 = *(const f32x4*)(Y1 + i), gm = bf4_to_f32(*(const u32x2*)(GM + i)), ga = bf4_to_f32(*(const u32x2*)(GA + i));
                        const f32x4 o = gm * y1 + ga * acc[ai][bj][m][n]; u32x2 w; w.x = cvt_pk_bf16(o[0], o[1]); w.y = cvt_pk_bf16(o[2], o[3]); *(u32x2*)(O + i) = w; } }
    }
};
struct EpiResidXF {
    static constexpr bool PERM = false, AFTER_DRAIN = false; const float* xp; const float* xs; const float* mod; float* O; int goff, pad;
    __device__ __forceinline__ void operator()(const f32x4 (&acc)[2][2][4][2], const Unit& u, int wr, int wc, int fr, int fq) const {
        const int row0 = u.pm * BM + wr * 64 + fr, col0 = u.pn * BM + wc * 32 + 4 * fq;
        const float* xb = u.pm < 16 ? xp : xs - (size_t)4096 * 1024; const float* md = mod + (u.pm < 16 ? 0 : 1 + ((u.pm - 16) >> 4)) * 6144 + goff;
#pragma unroll
        for (int ai = 0; ai < 2; ++ai)
#pragma unroll
            for (int m = 0; m < 4; ++m) { const size_t ro = (size_t)(row0 + ai * HALF + m * 16) * 1024 + col0;
#pragma unroll
                for (int bj = 0; bj < 2; ++bj)
#pragma unroll
                    for (int n = 0; n < 2; ++n) { const int c = col0 + bj * HALF + n * 16; const size_t i = ro + bj * HALF + n * 16;
                        *(f32x4*)(O + i) = *(const f32x4*)(xb + i) * 1.189207115002721f + *(const f32x4*)(md + c) * acc[ai][bj][m][n]; } }
    }
};
struct EpiResidInF {
    static constexpr bool PERM = false, AFTER_DRAIN = false; const float* mod; float* O; int goff, pad;
    __device__ __forceinline__ void operator()(const f32x4 (&acc)[2][2][4][2], const Unit& u, int wr, int wc, int fr, int fq) const {
        const int row0 = u.pm * BM + wr * 64 + fr, col0 = u.pn * BM + wc * 32 + 4 * fq;
        const float* md = mod + (u.pm < 16 ? 0 : 1 + ((u.pm - 16) >> 4)) * 6144 + goff;
#pragma unroll
        for (int ai = 0; ai < 2; ++ai)
#pragma unroll
            for (int m = 0; m < 4; ++m) { const size_t ro = (size_t)(row0 + ai * HALF + m * 16) * 1024 + col0;
#pragma unroll
                for (int bj = 0; bj < 2; ++bj)
#pragma unroll
                    for (int n = 0; n < 2; ++n) { const int c = col0 + bj * HALF + n * 16; const size_t i = ro + bj * HALF + n * 16;
                        *(f32x4*)(O + i) = *(const f32x4*)(O + i) * 1.189207115002721f + *(const f32x4*)(md + c) * acc[ai][bj][m][n]; } }
    }
};
struct EpiRelu2F {
    static constexpr bool PERM = true, AFTER_DRAIN = false; bf16_t* O; int ld, pad;
    __device__ __forceinline__ void operator()(const f32x4 (&acc)[2][2][4][2], const Unit& u, int wr, int wc, int fr, int fq) const {
        const int row0 = u.pm * BM + wr * 64 + fr, col0 = u.pn * BM + wc * 32 + 8 * fq;
#pragma unroll
        for (int ai = 0; ai < 2; ++ai)
#pragma unroll
            for (int m = 0; m < 4; ++m) { bf16_t* rowp = O + (size_t)(row0 + ai * HALF + m * 16) * ld + col0;
#pragma unroll
                for (int bj = 0; bj < 2; ++bj) { f32x4 v0 = acc[ai][bj][m][0], v1 = acc[ai][bj][m][1];
#pragma unroll
                    for (int e = 0; e < 4; ++e) { const float a = fmaxf(v0[e], 0.f), b = fmaxf(v1[e], 0.f); v0[e] = a * a; v1[e] = b * b; }
                    u32x4 w; w.x = cvt_pk_bf16(v0[0], v0[1]); w.y = cvt_pk_bf16(v0[2], v0[3]); w.z = cvt_pk_bf16(v1[0], v1[1]); w.w = cvt_pk_bf16(v1[2], v1[3]);
                    *(u32x4*)(rowp + bj * HALF) = w; } }
    }
};
template <class Epi, class Sched, bool ALIGN_EPI = false, bool SP2 = false>
__device__ __forceinline__ void gemm_phase(PG8_LAS unsigned char* lds, const Gemm g, const Sched& S, const Epi& E) {
    const int tid = threadIdx.x, wid = __builtin_amdgcn_readfirstlane(tid >> 6), lane = tid & 63, wr = wid >> 2, wc = wid & 3, fr = lane & 15, fq = lane >> 4;
    const int K = g.K, nt = K / BK;
    unsigned voffA[2], voffB[2];
#pragma unroll
    for (int i = 0; i < 2; ++i) { int R, C; stage_rc(tid * 16 + i * 8192, R, C); const int Rb = Epi::PERM ? ((R & ~31) + perm32(R & 31)) : R;
        voffA[i] = (unsigned)(R * g.lda + C) * 2u; voffB[i] = (unsigned)(Rb * g.ldb + C) * 2u; }
    const size_t kstep = (size_t)(BK * 2);
    const size_t hstepA = (size_t)HALF * g.lda * 2, hstepB = (size_t)HALF * g.ldb * 2;
    const unsigned ldsw = (unsigned)wid * 1024u;
    const int aoff = lds_byte(wr * 64 + fr, fq * 8), boff = lds_byte(wc * 32 + fr, fq * 8);
#define PG8_SA(b, h) (((b) * 2 + (h)) * HTB)
#define PG8_SB(b, h) ((4 + (b) * 2 + (h)) * HTB)
#define PG8_STAGE(bufoff, gbase, voff) do { _Pragma("unroll") for (int _i = 0; _i < 2; ++_i) \
        __builtin_amdgcn_global_load_lds((const unsigned*)((const char*)(gbase) + (voff)[_i]), (PG8_LAS unsigned*)(lds + (bufoff) + ldsw + _i * 8192), 16, 0, 0); } while (0)
#define PG8_LDA(dst, b, h) do { _Pragma("unroll") for (int m = 0; m < 4; ++m) _Pragma("unroll") for (int k = 0; k < 2; ++k) dst[m][k] = *(const PG8_LAS bf16x8*)(lds + PG8_SA(b, h) + aoff + m * 2048 + k * 1024); } while (0)
#define PG8_LDB(dst, b, h) do { _Pragma("unroll") for (int n = 0; n < 2; ++n) _Pragma("unroll") for (int k = 0; k < 2; ++k) dst[n][k] = *(const PG8_LAS bf16x8*)(lds + PG8_SB(b, h) + boff + n * 2048 + k * 1024); } while (0)
#define PG8_MMA(ai, bj, At, Bt) do { __builtin_amdgcn_s_setprio(1); _Pragma("unroll") for (int m = 0; m < 4; ++m) _Pragma("unroll") for (int n = 0; n < 2; ++n) _Pragma("unroll") for (int k = 0; k < 2; ++k) \
        acc[ai][bj][m][n] = __builtin_amdgcn_mfma_f32_16x16x32_bf16(Bt[n][k], At[m][k], acc[ai][bj][m][n], 0, 0, 0); __builtin_amdgcn_s_setprio(0); } while (0)
#define PG8_WAIT_V(n) asm volatile("s_waitcnt vmcnt(" #n ")" ::: "memory")
#define PG8_WAIT_L(n) asm volatile("s_waitcnt lgkmcnt(" #n ")" ::: "memory")
#define PG8_BAR __builtin_amdgcn_s_barrier()
#define PG8_SCHED __builtin_amdgcn_sched_barrier(0)
    Unit cur, nxt; int ui = 0;
    if (!S.next(0, cur)) return;
    f32x4 acc[2][2][4][2];
#pragma unroll
    for (int a = 0; a < 2; ++a)
#pragma unroll
        for (int b = 0; b < 2; ++b)
#pragma unroll
            for (int m = 0; m < 4; ++m)
#pragma unroll
                for (int n = 0; n < 2; ++n) acc[a][b][m][n] = (f32x4){0.f, 0.f, 0.f, 0.f};
    bf16x8 At[4][2], B0[2][2], B1[2][2];
    const char* cA = (const char*)g.A + S.a_off(cur); const char* cB = (const char*)g.Bt + S.b_off(cur);
    S.a_ready(cur);
    if constexpr (SP2) {
        PG8_STAGE(PG8_SB(0, 0), cB, voffB); PG8_STAGE(PG8_SB(0, 1), cB + hstepB, voffB); PG8_STAGE(PG8_SA(0, 0), cA, voffA); PG8_STAGE(PG8_SA(0, 1), cA + hstepA, voffA);
        if (wr == 1) PG8_BAR;
        PG8_WAIT_V(2); PG8_BAR;
        PG8_STAGE(PG8_SB(1, 0), cB + kstep, voffB); PG8_STAGE(PG8_SA(1, 0), cA + kstep, voffA); PG8_STAGE(PG8_SB(1, 1), cB + hstepB + kstep, voffB);
        PG8_WAIT_V(6); PG8_BAR;
    } else {
        PG8_STAGE(PG8_SB(0, 0), cB, voffB); PG8_STAGE(PG8_SA(0, 0), cA, voffA); PG8_STAGE(PG8_SB(0, 1), cB + hstepB, voffB); PG8_STAGE(PG8_SA(0, 1), cA + hstepA, voffA);
        if (wr == 1) PG8_BAR;
        PG8_WAIT_V(4); PG8_BAR;
        PG8_STAGE(PG8_SB(1, 0), cB + kstep, voffB); PG8_STAGE(PG8_SA(1, 0), cA + kstep, voffA); PG8_STAGE(PG8_SB(1, 1), cB + hstepB + kstep, voffB);
        PG8_WAIT_V(6); PG8_BAR;
    }
    for (;;) {
        const bool has_next = S.next(ui + 1, nxt);
        const char* nA = has_next ? (const char*)g.A + S.a_off(nxt) : cA; const char* nB = has_next ? (const char*)g.Bt + S.b_off(nxt) : cB;
        for (int t = 0; t < nt; t += 2) {
            const bool last = (t == nt - 2);
            const char* a1 = cA + (size_t)(t + 1) * kstep;
            const char* a2 = last ? nA : cA + (size_t)(t + 2) * kstep; const char* b2 = last ? nB : cB + (size_t)(t + 2) * kstep;
            const char* a3 = a2 + kstep; const char* b3 = b2 + kstep;
            if (last && has_next) S.a_ready(nxt);
            if constexpr (SP2) {
            PG8_LDB(B0, 0, 0); PG8_LDB(B1, 0, 1); PG8_SCHED; PG8_LDA(At, 0, 0); PG8_STAGE(PG8_SA(1, 1), a1 + hstepA, voffA);
            PG8_WAIT_V(8); PG8_WAIT_L(0); PG8_BAR; PG8_MMA(0, 0, At, B0); PG8_MMA(0, 1, At, B1); PG8_BAR; PG8_SCHED;
            PG8_LDA(At, 0, 1); PG8_STAGE(PG8_SB(0, 0), b2, voffB); PG8_STAGE(PG8_SB(0, 1), b2 + hstepB, voffB); PG8_STAGE(PG8_SA(0, 0), a2, voffA);
            PG8_WAIT_V(8); PG8_WAIT_L(0); PG8_BAR; PG8_MMA(1, 0, At, B0); PG8_MMA(1, 1, At, B1); PG8_BAR; PG8_SCHED;
            PG8_LDB(B0, 1, 0); PG8_LDB(B1, 1, 1); PG8_SCHED; PG8_LDA(At, 1, 0); PG8_STAGE(PG8_SA(0, 1), a2 + hstepA, voffA);
            PG8_WAIT_V(8); PG8_WAIT_L(0); PG8_BAR; PG8_MMA(0, 0, At, B0); PG8_MMA(0, 1, At, B1); PG8_BAR; PG8_SCHED;
            PG8_LDA(At, 1, 1); PG8_STAGE(PG8_SB(1, 0), b3, voffB); PG8_STAGE(PG8_SB(1, 1), b3 + hstepB, voffB); PG8_STAGE(PG8_SA(1, 0), a3, voffA);
            PG8_WAIT_V(8); PG8_WAIT_L(0); PG8_BAR; PG8_MMA(1, 0, At, B0); PG8_MMA(1, 1, At, B1); PG8_BAR; PG8_SCHED;
            } else {
            PG8_LDB(B0, 0, 0); PG8_SCHED; PG8_LDA(At, 0, 0); PG8_STAGE(PG8_SA(1, 1), a1 + hstepA, voffA);
            PG8_WAIT_L(8); PG8_BAR; PG8_WAIT_L(0); PG8_MMA(0, 0, At, B0); PG8_BAR; PG8_SCHED;
            PG8_LDB(B1, 0, 1); PG8_STAGE(PG8_SB(0, 0), b2, voffB);
            PG8_BAR; PG8_WAIT_L(0); PG8_MMA(0, 1, At, B1); PG8_BAR;
            PG8_LDA(At, 0, 1); PG8_STAGE(PG8_SA(0, 0), a2, voffA);
            PG8_BAR; PG8_WAIT_L(0); PG8_MMA(1, 0, At, B0); PG8_BAR; PG8_SCHED;
            PG8_STAGE(PG8_SB(0, 1), b2 + hstepB, voffB);
            PG8_WAIT_V(6); PG8_BAR; PG8_MMA(1, 1, At, B1); PG8_BAR;
            PG8_LDB(B0, 1, 0); PG8_SCHED; PG8_LDA(At, 1, 0); PG8_STAGE(PG8_SA(0, 1), a2 + hstepA, voffA);
            PG8_WAIT_L(8); PG8_BAR; PG8_WAIT_L(0); PG8_MMA(0, 0, At, B0); PG8_BAR; PG8_SCHED;
            PG8_LDB(B1, 1, 1); PG8_STAGE(PG8_SB(1, 0), b3, voffB);
            PG8_BAR; PG8_WAIT_L(0); PG8_MMA(0, 1, At, B1); PG8_BAR;
            PG8_LDA(At, 1, 1); PG8_STAGE(PG8_SA(1, 0), a3, voffA);
            PG8_BAR; PG8_WAIT_L(0); PG8_MMA(1, 0, At, B0); PG8_BAR; PG8_SCHED;
            PG8_STAGE(PG8_SB(1, 1), b3 + hstepB, voffB);
            PG8_WAIT_V(6); PG8_BAR; PG8_MMA(1, 1, At, B1); PG8_BAR;
            }
        }
        if constexpr (ALIGN_EPI) { if (wr == 0) PG8_BAR; }
        if constexpr (!Epi::AFTER_DRAIN) { E(acc, cur, wr, wc, fr, fq); S.done(cur); }
        if (!has_next) break;
#pragma unroll
        for (int a = 0; a < 2; ++a)
#pragma unroll
            for (int b = 0; b < 2; ++b)
#pragma unroll
                for (int m = 0; m < 4; ++m)
#pragma unroll
                    for (int n = 0; n < 2; ++n) acc[a][b][m][n] = (f32x4){0.f, 0.f, 0.f, 0.f};
        cur = nxt; cA = nA; cB = nB; ++ui;
        if constexpr (ALIGN_EPI) { if (wr == 1) PG8_BAR; }
    }
    PG8_WAIT_V(0);
    if constexpr (!ALIGN_EPI) { if (wr == 0) PG8_BAR; }
    PG8_BAR;
    if constexpr (Epi::AFTER_DRAIN) { E.fused(acc, cur, wr, wc, fr, fq, lds, wid, lane); S.done(cur); }
#undef PG8_SA
#undef PG8_SB
#undef PG8_STAGE
#undef PG8_LDA
#undef PG8_LDB
#undef PG8_MMA
#undef PG8_WAIT_V
#undef PG8_WAIT_L
#undef PG8_BAR
#undef PG8_SCHED
}
}


namespace fa {
using bf16 = unsigned short;
constexpr int   D = 128, NW = 8, QBLK = 32, KVBLK = 64;
constexpr float SCALE = 0.088388347648318440f;
constexpr float THR = 8.f;
constexpr int SDEPTH = 2;
constexpr int LDQ = 1024, LDK = 256, LDO = 1024;
constexpr size_t SHM_V = KVBLK * D * 2, SHM_K = KVBLK * D * 2, SHM_ATTN = 2 * SHM_V + 2 * SHM_K + NW * 64 * 4;
using bf16x8 = __attribute__((ext_vector_type(8))) short;
using s16x4  = __attribute__((ext_vector_type(4))) short;
using f32x16 = __attribute__((ext_vector_type(16))) float;
using f32x8  = __attribute__((ext_vector_type(8))) float;
using u32x4  = __attribute__((ext_vector_type(4))) unsigned;
#define KSWZ(row, colB) ((row) * 256 + ((colB) ^ (((row) & 7) << 4)))
#define SBAR() __builtin_amdgcn_sched_barrier(0)
__device__ __forceinline__ int crow(int r, int hi) { return (r & 3) + 8 * (r >> 2) + 4 * hi; }
__device__ __forceinline__ unsigned cvtpk(float lo, float hi) {
  unsigned r; asm volatile("v_cvt_pk_bf16_f32 %0, %1, %2" : "=v"(r) : "v"(lo), "v"(hi)); return r;
}
template <typename TIn> struct Stage;
template <> struct Stage<bf16>  { using T = bf16x8;
  __device__ static __forceinline__ T ld8(const bf16* p) { return *reinterpret_cast<const bf16x8*>(p); }
  __device__ static __forceinline__ bf16x8 tobf(T x) { return x; } };
template <> struct Stage<float> { using T = f32x8;
  __device__ static __forceinline__ T ld8(const float* p) { return *reinterpret_cast<const f32x8*>(p); }
  __device__ static __forceinline__ bf16x8 tobf(T x) {
    u32x4 w = {cvtpk(x[0], x[1]), cvtpk(x[2], x[3]), cvtpk(x[4], x[5]), cvtpk(x[6], x[7])}; return *reinterpret_cast<bf16x8*>(&w); } };

__device__ __forceinline__ void partialSM(f32x16& p0, f32x16& p1, float& m_reg, float& mn, float& alpha) {
  constexpr float C = SCALE * 1.4426950408889634f;
  float pmax = p0[0]; for (int r = 1; r < 16; ++r) pmax = fmaxf(pmax, p0[r]); for (int r = 0; r < 16; ++r) pmax = fmaxf(pmax, p1[r]);
  { auto rr = __builtin_amdgcn_permlane32_swap(__float_as_uint(pmax), __float_as_uint(pmax), false, false);
    pmax = fmaxf(__uint_as_float(rr[0]), __uint_as_float(rr[1])); }
  if (__builtin_expect(__all(pmax - m_reg <= THR / SCALE), 1)) { mn = m_reg; alpha = 1.f; }
  else { mn = fmaxf(m_reg, pmax); alpha = __builtin_amdgcn_exp2f((m_reg - mn) * C); m_reg = mn; }
  float mnC = -mn * C;
  for (int r = 0; r < 16; ++r) p0[r] = fmaf(p0[r], C, mnC); for (int r = 0; r < 16; ++r) p1[r] = fmaf(p1[r], C, mnC);
  for (int r = 0; r < 16; ++r) p0[r] = __builtin_amdgcn_exp2f(p0[r]);
}
__device__ __forceinline__ void finishSM(f32x16& p0, f32x16& p1, float alpha, float& l_reg, bf16x8& pa0, bf16x8& pa1, bf16x8& pa2, bf16x8& pa3) {
  for (int r = 0; r < 16; ++r) p1[r] = __builtin_amdgcn_exp2f(p1[r]);
  float ps = 0; for (int r = 0; r < 16; ++r) ps += p0[r]; for (int r = 0; r < 16; ++r) ps += p1[r];
  { auto rr = __builtin_amdgcn_permlane32_swap(__float_as_uint(ps), __float_as_uint(ps), false, false);
    ps = __uint_as_float(rr[0]) + __uint_as_float(rr[1]); }
  l_reg = l_reg * alpha + ps;
#define PK4(P, BASE, OUT) do { unsigned a0 = cvtpk(P[BASE + 0], P[BASE + 1]), a1 = cvtpk(P[BASE + 2], P[BASE + 3]);   \
    unsigned b0 = cvtpk(P[BASE + 4], P[BASE + 5]), b1 = cvtpk(P[BASE + 6], P[BASE + 7]);                              \
    auto r0 = __builtin_amdgcn_permlane32_swap(a0, b0, false, false); auto r1 = __builtin_amdgcn_permlane32_swap(a1, b1, false, false); \
    u32x4 w = {r0[0], r1[0], r0[1], r1[1]}; OUT = *reinterpret_cast<bf16x8*>(&w); } while (0)
  PK4(p0, 0, pa0); PK4(p0, 8, pa1); PK4(p1, 0, pa2); PK4(p1, 8, pa3);
#undef PK4
}
__device__ __forceinline__ void qkt(f32x16& p0, f32x16& p1, const bf16* Ks, const bf16x8* qr, int r32, int hi) {
  p0 = f32x16{}; p1 = f32x16{};
  for (int d0 = 0; d0 < 8; ++d0) { int cb = (d0 * 16 + hi * 8) * 2;
    bf16x8 b0 = *reinterpret_cast<const bf16x8*>((const char*)Ks + KSWZ(r32, cb));
    bf16x8 b1 = *reinterpret_cast<const bf16x8*>((const char*)Ks + KSWZ(32 + r32, cb));
    p0 = __builtin_amdgcn_mfma_f32_32x32x16_bf16(b0, qr[d0], p0, 0, 0, 0);
    p1 = __builtin_amdgcn_mfma_f32_32x32x16_bf16(b1, qr[d0], p1, 0, 0, 0); }
}
__device__ __forceinline__ int v_st(int k, int c) { const int kk = (k & ~0xC) | ((k & 4) << 1) | ((k & 8) >> 1); return ((kk >> 3) * 4 + (c >> 5)) * 512 + ((kk & 7) * 32 + (c & 31)) * 2; }
__device__ __forceinline__ int v_rd_base(int lane) { return ((lane & 3) << 3) | (((lane >> 2) & 3) << 6) | (((lane >> 4) & 1) << 5) | (((lane >> 5) & 1) << 8); }
constexpr int v_rd_off(int d0, int ks, int half) { return d0 * 512 + ks * 4096 + half * 2048; }
template <int OFF> __device__ __forceinline__ s16x4 tr_read(int vb) {
  s16x4 r; asm volatile("ds_read_b64_tr_b16 %0, %1 offset:%2" : "=&v"(r) : "v"(vb), "i"(OFF) : "memory"); return r;
}
template <int D0> __device__ __forceinline__ void pv_one(f32x16& od, int vb, bf16x8 pa0, bf16x8 pa1, bf16x8 pa2, bf16x8 pa3) {
  const s16x4 l0 = tr_read<v_rd_off(D0, 0, 0)>(vb), h0 = tr_read<v_rd_off(D0, 0, 1)>(vb), l1 = tr_read<v_rd_off(D0, 1, 0)>(vb), h1 = tr_read<v_rd_off(D0, 1, 1)>(vb);
  const s16x4 l2 = tr_read<v_rd_off(D0, 2, 0)>(vb), h2 = tr_read<v_rd_off(D0, 2, 1)>(vb), l3 = tr_read<v_rd_off(D0, 3, 0)>(vb), h3 = tr_read<v_rd_off(D0, 3, 1)>(vb);
  asm volatile("s_waitcnt lgkmcnt(0)" ::: "memory"); SBAR();
#define PK(L, H) (bf16x8){L[0], L[1], L[2], L[3], H[0], H[1], H[2], H[3]}
  od = __builtin_amdgcn_mfma_f32_32x32x16_bf16(pa0, PK(l0, h0), od, 0, 0, 0);
  od = __builtin_amdgcn_mfma_f32_32x32x16_bf16(pa1, PK(l1, h1), od, 0, 0, 0);
  od = __builtin_amdgcn_mfma_f32_32x32x16_bf16(pa2, PK(l2, h2), od, 0, 0, 0);
  od = __builtin_amdgcn_mfma_f32_32x32x16_bf16(pa3, PK(l3, h3), od, 0, 0, 0);
#undef PK
}
__device__ __forceinline__ void pv_d0(f32x16* o, int vb, bf16x8 pa0, bf16x8 pa1, bf16x8 pa2, bf16x8 pa3) {
  pv_one<0>(o[0], vb, pa0, pa1, pa2, pa3); pv_one<1>(o[1], vb, pa0, pa1, pa2, pa3); pv_one<2>(o[2], vb, pa0, pa1, pa2, pa3); pv_one<3>(o[3], vb, pa0, pa1, pa2, pa3);
}

template <typename TQ>
__device__ __forceinline__ void attn_dense_body(const TQ* Qb, const bf16* __restrict__ Kh, const bf16* __restrict__ Vh,
                                                bf16* Ob, int seq, char* lds) {
  using St = Stage<bf16>; using SQ = Stage<TQ>;
  const int tid = threadIdx.x, wid = tid >> 6, lane = tid & 63, r32 = lane & 31, hi = lane >> 5;
  bf16* V_lds = (bf16*)lds; bf16* K_lds = (bf16*)(lds + 2 * SHM_V);
  float* ws = (float*)(lds + 2 * SHM_V + 2 * SHM_K) + wid * 64; float* li_l = ws; float* al_l = ws + 32;
  float m_reg = -1e30f, l_reg = 0; f32x16 o[4] = {}; bf16x8 qr[8];
  const TQ* Qw = Qb + (long)(wid * QBLK + r32) * LDQ + hi * 8;
#pragma unroll
  for (int d0 = 0; d0 < 8; ++d0) qr[d0] = SQ::tobf(SQ::ld8(Qw + d0 * 16));
  const int sr = tid >> 4, sc = (tid & 15) * 8, vst0 = v_st(sr, sc), vst1 = v_st(32 + sr, sc);
  const int vb0 = (int)(uintptr_t)V_lds + v_rd_base(lane);
  struct { typename St::T vs0, vs1, ks0, ks1; } sr_[SDEPTH];
#define SLOAD(i, k0) do { sr_[i].vs0 = St::ld8(&Vh[(long)((k0) + sr) * LDK + sc]); sr_[i].vs1 = St::ld8(&Vh[(long)((k0) + 32 + sr) * LDK + sc]); \
    sr_[i].ks0 = St::ld8(&Kh[(long)((k0) + sr) * LDK + sc]); sr_[i].ks1 = St::ld8(&Kh[(long)((k0) + 32 + sr) * LDK + sc]); } while (0)
#define SWRITE(b, i) do { *(bf16x8*)((char*)V_lds + (b) * SHM_V + vst0) = St::tobf(sr_[i].vs0);          \
    *(bf16x8*)((char*)V_lds + (b) * SHM_V + vst1) = St::tobf(sr_[i].vs1); int kc = sc * 2;               \
    *(bf16x8*)((char*)K_lds + (b) * SHM_K + KSWZ(sr, kc)) = St::tobf(sr_[i].ks0);                       \
    *(bf16x8*)((char*)K_lds + (b) * SHM_K + KSWZ(32 + sr, kc)) = St::tobf(sr_[i].ks1); } while (0)
#define SWAIT() do { if constexpr (SDEPTH == 2) asm volatile("s_waitcnt vmcnt(4)" ::: "memory"); else asm volatile("s_waitcnt vmcnt(0)" ::: "memory"); } while (0)
#define RESC(a) do { if (__any((a) < 1.f)) { if (hi == 0) al_l[r32] = (a); asm volatile("s_waitcnt lgkmcnt(0)" ::: "memory"); \
    for (int d = 0; d < 4; ++d) for (int r = 0; r < 16; ++r) o[d][r] *= al_l[crow(r, hi)]; } } while (0)
  f32x16 pA0, pA1, pB0, pB1; float mnA, mnB, alA, alB; bf16x8 pa0, pa1, pa2, pa3; const int NT = seq / KVBLK;
  constexpr int SE = 0, SO = SDEPTH - 1;
  SLOAD(SE, 0); asm volatile("s_waitcnt vmcnt(0)" ::: "memory"); SWRITE(0, SE); __syncthreads();
  qkt(pA0, pA1, K_lds, qr, r32, hi); partialSM(pA0, pA1, m_reg, mnA, alA);
  SLOAD(SO, KVBLK); if constexpr (SDEPTH == 2) { if (2 < NT) SLOAD(SE, 2 * KVBLK); }
  SWAIT(); SWRITE(1, SO); __syncthreads();
  for (int j = 1; j + 1 < NT; j += 2) {
    SBAR(); qkt(pB0, pB1, (bf16*)((char*)K_lds + SHM_K), qr, r32, hi);
    finishSM(pA0, pA1, alA, l_reg, pa0, pa1, pa2, pa3); SBAR();
    SLOAD(SO, (j + SDEPTH) * KVBLK); SBAR();
    pv_d0(o, vb0, pa0, pa1, pa2, pa3); partialSM(pB0, pB1, m_reg, mnB, alB);
    __syncthreads(); SWAIT(); SWRITE(0, SE);
    RESC(alB); __syncthreads();
    SBAR(); qkt(pA0, pA1, K_lds, qr, r32, hi);
    finishSM(pB0, pB1, alB, l_reg, pa0, pa1, pa2, pa3); SBAR();
    if (SDEPTH == 1 || j + 3 < NT) SLOAD(SE, (j + 1 + SDEPTH) * KVBLK); SBAR();
    pv_d0(o, vb0 + (int)SHM_V, pa0, pa1, pa2, pa3); partialSM(pA0, pA1, m_reg, mnA, alA);
    __syncthreads(); SWAIT(); SWRITE(1, SO);
    RESC(alA); __syncthreads();
  }
  SBAR(); qkt(pB0, pB1, (bf16*)((char*)K_lds + SHM_K), qr, r32, hi);
  finishSM(pA0, pA1, alA, l_reg, pa0, pa1, pa2, pa3); SBAR();
  pv_d0(o, vb0, pa0, pa1, pa2, pa3); partialSM(pB0, pB1, m_reg, mnB, alB);
  __syncthreads(); RESC(alB);
  finishSM(pB0, pB1, alB, l_reg, pa0, pa1, pa2, pa3); SBAR();
  pv_d0(o, vb0 + (int)SHM_V, pa0, pa1, pa2, pa3);
  if (hi == 0) li_l[r32] = l_reg; asm volatile("s_waitcnt lgkmcnt(0)" ::: "memory");
  float rli[16];
#pragma unroll
  for (int r = 0; r < 16; ++r) rli[r] = __builtin_amdgcn_rcpf(li_l[crow(r, hi)]);
  bf16* Ow = Ob + (long)(wid * QBLK) * LDO;
#pragma unroll
  for (int r = 0; r < 16; ++r) { int orow = crow(r, hi);
    for (int d0 = 0; d0 < 4; ++d0) Ow[(long)orow * LDO + d0 * 32 + r32] = f2bf(o[d0][r] * rli[r]); }
#undef SLOAD
#undef SWRITE
#undef SWAIT
#undef RESC
}

}

__device__ __forceinline__ void attn_phase(bf16_t* QA, const bf16_t* KA, const bf16_t* VA, char* lds, int vcu, int G) {
    for (int u = vcu; u < 384; u += G) {
        bf16_t* Q; const bf16_t* K; const bf16_t* V; int seq;
        if (u < 256) { const int grp = u >> 6, b = grp >> 1, kvh = grp & 1, g = (u >> 4) & 3, qb = u & 15, head = kvh * 4 + g;
            Q = QA + (size_t)(NCTX + b * TLAT + qb * 256) * 1024 + head * 128; const size_t ko = (size_t)(NCTX + b * KV_ROWS_LAT) * 256 + kvh * 128; K = KA + ko; V = VA + ko; seq = KV_ROWS_LAT; }
        else { const int c = u - 256, s = c >> 3, head = c & 7;
            Q = QA + (size_t)(s * 256) * 1024 + head * 128; const size_t ko = (size_t)(s * 256) * 256 + (head >> 2) * 128; K = KA + ko; V = VA + ko; seq = TCTX; }
        fa::attn_dense_body<fa::bf16>(Q, K, V, Q, seq, lds);
        __syncthreads();
    }
}
__global__ void __launch_bounds__(512, 2) k_fattn(bf16_t* QA, const bf16_t* KA, const bf16_t* VA) {
    extern __shared__ __attribute__((aligned(16))) unsigned char lds_dyn[];
    const int G = gridDim.x, bx = blockIdx.x, vcu = (G % 8 == 0) ? (bx % 8) * (G / 8) + bx / 8 : bx;
    attn_phase(QA, KA, VA, (char*)lds_dyn, vcu, G);
}

constexpr int FG_LDS = 147456;
template <class Epi> __global__ void __launch_bounds__(512, 2) k_fgemm(pg8::Gemm g, Epi E) {
    extern __shared__ __attribute__((aligned(16))) unsigned char lds_dyn[];
    pg8::StaticOrder S; S.init(g.M, g.N, (int)gridDim.x, (int)blockIdx.x, g.lda, g.ldb);
    pg8::gemm_phase<Epi, pg8::StaticOrder, true, true>((PG8_LAS unsigned char*)lds_dyn, g, S, E);
}
template <class Epi> __global__ void __launch_bounds__(512, 2) k_ugemm(pg8::Gemm g, Epi E, int mode, int pad_) {
    extern __shared__ __attribute__((aligned(16))) unsigned char lds_dyn[];
    pg8::UOrder S; S.init((int)gridDim.x, (int)blockIdx.x, mode);
    pg8::gemm_phase<Epi, pg8::UOrder, true, true>((PG8_LAS unsigned char*)lds_dyn, g, S, E);
}
__global__ void __launch_bounds__(64) k_scan(const float* __restrict__ gates, const float* __restrict__ sM, float* __restrict__ SC, float* __restrict__ CH, float* __restrict__ oM) {
    const int chain = blockIdx.x, lane = threadIdx.x; const bool ctx = chain < 128;
    int dirh, T, row0, b = 0; float m = 0.f;
    if (ctx) { dirh = chain & 7; T = TCTX; row0 = (chain >> 3) * TCTX; }
    else { const int cl = chain - 128; b = cl >> 3; dirh = cl & 7; T = TLAT; row0 = NCTX + b * TLAT; m = sM[b * 8 + dirh]; }
    const int dir = dirh >> 2, h = dirh & 3, nc = T / 256;
    for (int ci = 0; ci < nc; ++ci) {
        const int c = dir ? nc - 1 - ci : ci, tok0 = row0 + c * 256;
        float ig[4], lb[4], a[4], pm_[4]; int tok[4];
        float run = 0.f;
#pragma unroll
        for (int e = 0; e < 4; ++e) { const int p = 4 * lane + e; tok[e] = dir ? tok0 + 255 - p : tok0 + p;
            ig[e] = gates[(size_t)tok[e] * 16 + dir * 8 + h]; const float fp = gates[(size_t)tok[e] * 16 + dir * 8 + 4 + h];
            const float lf = fminf(fp, 0.f) - log1pf(expf(-fabsf(fp))); run += lf; lb[e] = run; }
        float incl = run;
#pragma unroll
        for (int off = 1; off < 64; off <<= 1) { const float v = __shfl_up(incl, off); if (lane >= off) incl += v; }
        const float excl = incl - run, F = __shfl(incl, 63);
        float lm = -3.0e38f;
#pragma unroll
        for (int e = 0; e < 4; ++e) { lb[e] += excl; a[e] = ig[e] - lb[e]; lm = fmaxf(lm, a[e]); pm_[e] = lm; }
        float inm = lm;
#pragma unroll
        for (int off = 1; off < 64; off <<= 1) { const float v = __shfl_up(inm, off); if (lane >= off) inm = fmaxf(inm, v); }
        float exm = __shfl_up(inm, 1); if (lane == 0) exm = -3.0e38f;
        const float A = __shfl(inm, 63);
#pragma unroll
        for (int e = 0; e < 4; ++e) { const float M = fmaxf(m, fmaxf(exm, pm_[e])); const size_t idx = (size_t)dirh * MTOK + tok[e];
            SC[SC_A * SC_STRIDE + idx] = a[e]; SC[SC_M * SC_STRIDE + idx] = M; SC[SC_WU * SC_STRIDE + idx] = expf(a[e] - A);
            SC[SC_WI * SC_STRIDE + idx] = expf(m - M); SC[SC_FL * SC_STRIDE + idx] = expf(-(lb[e] + M)); }
        const float Mx = fmaxf(m, A), alpha = expf(m - Mx), beta = expf(A - Mx), mnext = F + Mx;
        if (lane == 0) { if (ctx) { CH[CH_BETAC + chain] = beta; oM[chain] = mnext; } else { CH[CH_ALPHA + (b * 8 + dirh) * 16 + c] = alpha; CH[CH_BETA + (b * 8 + dirh) * 16 + c] = beta; } }
        m = mnext;
    }
}
__global__ void __launch_bounds__(256) k_un(const bf16_t* __restrict__ KT, const float* __restrict__ CH, float* __restrict__ oN, float* __restrict__ UN) {
    const int id = blockIdx.x, d = threadIdx.x; int dirh, tok0, slot = 0; const bool ctx = id < 128;
    if (ctx) { dirh = id & 7; tok0 = (id >> 3) * 256; }
    else { const int l = id - 128, b = l / 120, rem = l % 120, ci = rem % 15; dirh = rem / 15; const int c = (dirh >> 2) ? ci + 1 : ci; tok0 = NCTX + b * TLAT + c * 256; slot = (b * 8 + dirh) * 16 + c; }
    const bf16_t* p = KT + (size_t)((dirh >> 2) * 1024 + (dirh & 3) * 256 + d) * MTOK + tok0;
    float s = 0.f;
    for (int t = 0; t < 256; t += 8) { const pg8::u32x4 w = *(const pg8::u32x4*)(p + t);
        s += __uint_as_float(w.x << 16) + __uint_as_float(w.x & 0xffff0000u) + __uint_as_float(w.y << 16) + __uint_as_float(w.y & 0xffff0000u)
           + __uint_as_float(w.z << 16) + __uint_as_float(w.z & 0xffff0000u) + __uint_as_float(w.w << 16) + __uint_as_float(w.w & 0xffff0000u); }
    if (ctx) oN[(size_t)id * 256 + d] = CH[CH_BETAC + id] * s; else UN[(size_t)slot * 256 + d] = s;
}
__global__ void __launch_bounds__(512) k_cscan(const float* __restrict__ sC, const float* __restrict__ sN, const bf16_t* __restrict__ UT, const float* __restrict__ UN, const float* __restrict__ CH,
                                                bf16_t* __restrict__ CT, float* __restrict__ NT) {
    const int t = blockIdx.x * 512 + threadIdx.x, dg = t & 31, e = (t >> 5) & 255, chain = t >> 13;
    const int dirh = chain & 7, dir = dirh >> 2;
    float C[8];
#pragma unroll
    for (int j = 0; j < 8; ++j) C[j] = sC[(size_t)chain * 65536 + (size_t)(dg * 8 + j) * 256 + e];
    for (int i = 0; i < 16; ++i) {
        const int c = dir ? 15 - i : i; const size_t so = ((size_t)(chain * 16 + c) * 256 + e) * 256 + dg * 8;
        pg8::u32x4 w; w.x = pg8::cvt_pk_bf16(C[0], C[1]); w.y = pg8::cvt_pk_bf16(C[2], C[3]); w.z = pg8::cvt_pk_bf16(C[4], C[5]); w.w = pg8::cvt_pk_bf16(C[6], C[7]);
        *(pg8::u32x4*)(CT + so) = w;
        if (i == 15) break;
        const float al = CH[CH_ALPHA + chain * 16 + c], be = CH[CH_BETA + chain * 16 + c];
        const pg8::u32x4 u = *(const pg8::u32x4*)(UT + so);
        const float uf[8] = {__uint_as_float(u.x << 16), __uint_as_float(u.x & 0xffff0000u), __uint_as_float(u.y << 16), __uint_as_float(u.y & 0xffff0000u),
                             __uint_as_float(u.z << 16), __uint_as_float(u.z & 0xffff0000u), __uint_as_float(u.w << 16), __uint_as_float(u.w & 0xffff0000u)};
#pragma unroll
        for (int j = 0; j < 8; ++j) C[j] = al * C[j] + be * uf[j];
    }
    if (t < 16 * 256) {
        const int ch2 = t >> 8, d = t & 255, dir2 = (ch2 & 7) >> 2; float n = sN[(size_t)ch2 * 256 + d];
        for (int i = 0; i < 16; ++i) { const int c = dir2 ? 15 - i : i; NT[(size_t)(ch2 * 16 + c) * 256 + d] = n; if (i == 15) break;
            n = CH[CH_ALPHA + ch2 * 16 + c] * n + CH[CH_BETA + ch2 * 16 + c] * UN[(size_t)(ch2 * 16 + c) * 256 + d]; }
    }
}

namespace hu {
using pg8::bf16x8; using pg8::f32x4; using pg8::u32x4; using pg8::u32x2;
constexpr int KT_STRIDE = 528, BT_STRIDE = 144;
constexpr int L_KT = 0, L_BT = 64 * KT_STRIDE, L_A = L_BT + 256 * BT_STRIDE, L_N = L_A + 256, L_DEN = L_N + 1024, L_HF = L_DEN + 512, L_END = L_HF + 65536;
__device__ __forceinline__ void hunit(int u, bf16_t* QM, const bf16_t* __restrict__ KM, const bf16_t* __restrict__ VT, const bf16_t* __restrict__ OM, const bf16_t* __restrict__ CT,
                                      const float* __restrict__ NT, const float* __restrict__ SC, const float* __restrict__ gm, unsigned char* lds) {
    const int tid = threadIdx.x, lane = tid & 63, w = __builtin_amdgcn_readfirstlane(tid >> 6), q = lane & 15, g = lane >> 4;
    int h, blk, rowbase, chain0 = 0; bool lat;
    if (u < 256) { lat = true; const int b = u >> 7; h = (u >> 5) & 3; blk = u & 31; rowbase = NCTX + b * TLAT; chain0 = b * 8; }
    else { lat = false; const int c2 = u - 256; h = (c2 >> 1) & 3; blk = c2 & 1; rowbase = (c2 >> 3) * TCTX; }
    const int c = blk >> 1, half = blk & 1, cstart = rowbase + c * 256, R0 = cstart + half * 128, qrel = half * 128 + 16 * w + q;
    const int myrow = R0 + 16 * w + q;
    const int arow0 = R0 + 16 * w + 4 * g;
    bf16x8 qf[8];
#pragma unroll
    for (int s = 0; s < 8; ++s) qf[s] = *(const bf16x8*)(QM + (size_t)myrow * 1024 + h * 256 + 32 * s + 8 * g);
    f32x4 O[16];
    float* a_s = (float*)(lds + L_A); float* n_s = (float*)(lds + L_N); float* den_s = (float*)(lds + L_DEN) + w * 16;
#pragma unroll 1
    for (int dir = 0; dir < 2; ++dir) {
        const int dirh = dir * 4 + h; const size_t sco = (size_t)dirh * MTOK;
        const float Mq = SC[SC_M * SC_STRIDE + sco + myrow], flq = SC[SC_FL * SC_STRIDE + sco + myrow];
#pragma unroll
        for (int eb = 0; eb < 16; ++eb) O[eb] = (f32x4){0.f, 0.f, 0.f, 0.f};
        float den = 0.f;
        if (lat) {
            const size_t slot = (size_t)(chain0 + dirh) * 16 + c; const bf16_t* Cs = CT + slot * 65536;
#pragma unroll
            for (int ds = 0; ds < 4; ++ds) {
                { const bf16_t* cp = Cs + (tid >> 1) * 256 + (tid & 1) * 32 + 64 * ds; unsigned char* dp = lds + L_BT + (tid >> 1) * BT_STRIDE + (tid & 1) * 64;
#pragma unroll
                  for (int i = 0; i < 4; ++i) *(u32x4*)(dp + i * 16) = *(const u32x4*)(cp + i * 8); }
                if (ds == 0 && tid < 256) n_s[tid] = NT[slot * 256 + tid];
                __syncthreads();
#pragma unroll
                for (int eb = 0; eb < 16; ++eb)
#pragma unroll
                    for (int ks = 0; ks < 2; ++ks) { const bf16x8 B = *(const bf16x8*)(lds + L_BT + (16 * eb + q) * BT_STRIDE + (32 * ks + 8 * g) * 2);
                        O[eb] = __builtin_amdgcn_mfma_f32_16x16x32_bf16(qf[2 * ds + ks], B, O[eb], 0, 0, 0); if ((eb & 3) == 3 && ks == 1) __builtin_amdgcn_sched_barrier(0); }
                if (ds == 0) {
                    float dn = 0.f;
#pragma unroll
                    for (int s = 0; s < 8; ++s)
#pragma unroll
                        for (int j = 0; j < 8; ++j) dn += __uint_as_float(((unsigned)(unsigned short)qf[s][j]) << 16) * n_s[32 * s + 8 * g + j];
                    __builtin_amdgcn_sched_barrier(0);
                    dn += __shfl_xor(dn, 16); dn += __shfl_xor(dn, 32);
                    den = dn * SC[SC_WI * SC_STRIDE + sco + myrow];
                }
                __syncthreads();
            }
            const f32x4 wi = *(const f32x4*)(SC + SC_WI * SC_STRIDE + sco + arow0);
#pragma unroll
            for (int eb = 0; eb < 16; ++eb) O[eb] = O[eb] * wi;
        }
        const int jt0 = dir == 0 ? 0 : (half ? 2 : 0), jt1 = dir == 0 ? (half ? 3 : 1) : 3;
        float dsum = 0.f;
#pragma unroll 1
        for (int jt = jt0; jt <= jt1; ++jt) {
            const int KR0 = cstart + 64 * jt;
            { const bf16_t* kp = KM + (size_t)(KR0 + (tid >> 3)) * 1024 + h * 256 + (tid & 7) * 8; unsigned char* kd = lds + L_KT + (tid >> 3) * KT_STRIDE + (tid & 7) * 16;
              const bf16_t* vp = VT + (size_t)(h * 256 + (tid >> 1)) * MTOK + KR0 + (tid & 1) * 32; unsigned char* vd = lds + L_BT + (tid >> 1) * BT_STRIDE + (tid & 1) * 64;
#pragma unroll
              for (int i = 0; i < 4; ++i) { *(u32x4*)(kd + i * 128) = *(const u32x4*)(kp + i * 64); *(u32x4*)(vd + i * 16) = *(const u32x4*)(vp + i * 8); } }
            if (tid < 64) a_s[tid] = SC[SC_A * SC_STRIDE + sco + KR0 + tid];
            __syncthreads();
            const int rlo = half * 128 + 16 * w, rhi = rlo + 15, klo = 64 * jt, khi = klo + 63;
            const bool active = dir == 0 ? (klo <= rhi) : (khi >= rlo);
            if (active) {
                f32x4 st[4];
#pragma unroll
                for (int kb = 0; kb < 4; ++kb) { st[kb] = (f32x4){0.f, 0.f, 0.f, 0.f};
#pragma unroll
                    for (int s = 0; s < 8; ++s) { const bf16x8 A = *(const bf16x8*)(lds + L_KT + (16 * kb + q) * KT_STRIDE + (32 * s + 8 * g) * 2);
                        st[kb] = __builtin_amdgcn_mfma_f32_16x16x32_bf16(A, qf[s], st[kb], 0, 0, 0); } }
#pragma unroll
                for (int kb = 0; kb < 4; ++kb) { const f32x4 av = *(const f32x4*)(a_s + 16 * kb + 4 * g);
#pragma unroll
                    for (int r = 0; r < 4; ++r) { const int krel = klo + 16 * kb + 4 * g + r; const bool vis = dir == 0 ? (krel <= qrel) : (krel >= qrel);
                        const float p = vis ? st[kb][r] * __builtin_amdgcn_exp2f((av[r] - Mq) * 1.4426950408889634f) : 0.f; st[kb][r] = p; dsum += p; } }
#pragma unroll
                for (int s2 = 0; s2 < 2; ++s2) { u32x4 pw; pw.x = pg8::cvt_pk_bf16(st[2 * s2][0], st[2 * s2][1]); pw.y = pg8::cvt_pk_bf16(st[2 * s2][2], st[2 * s2][3]);
                    pw.z = pg8::cvt_pk_bf16(st[2 * s2 + 1][0], st[2 * s2 + 1][1]); pw.w = pg8::cvt_pk_bf16(st[2 * s2 + 1][2], st[2 * s2 + 1][3]);
                    const bf16x8 pa = __builtin_bit_cast(bf16x8, pw);
#pragma unroll
                    for (int eb = 0; eb < 16; ++eb) { const unsigned char* bp = lds + L_BT + (16 * eb + q) * BT_STRIDE + (32 * s2 + 4 * g) * 2;
                        const u32x2 lo = *(const u32x2*)bp, hi = *(const u32x2*)(bp + 32); u32x4 bw; bw.x = lo.x; bw.y = lo.y; bw.z = hi.x; bw.w = hi.y;
                        O[eb] = __builtin_amdgcn_mfma_f32_16x16x32_bf16(pa, __builtin_bit_cast(bf16x8, bw), O[eb], 0, 0, 0); if ((eb & 3) == 3) __builtin_amdgcn_sched_barrier(0); } }
            }
            __syncthreads();
        }
        dsum += __shfl_xor(dsum, 16); dsum += __shfl_xor(dsum, 32);
        den += dsum;
        if (g == 0) den_s[q] = 1.f / fmaxf(fabsf(den), flq);
        __syncthreads();
        const f32x4 rinv = *(const f32x4*)(den_s + 4 * g);
        __syncthreads();
        if (dir == 0) {
#pragma unroll
            for (int eb = 0; eb < 16; ++eb) { const f32x4 v = O[eb] * rinv; u32x2 pk; pk.x = pg8::cvt_pk_bf16(v[0], v[1]); pk.y = pg8::cvt_pk_bf16(v[2], v[3]); *(u32x2*)(lds + L_HF + eb * 4096 + tid * 8) = pk; }
        } else {
#pragma unroll
            for (int eb = 0; eb < 16; ++eb) O[eb] = O[eb] * rinv + pg8::bf4_to_f32(*(const u32x2*)(lds + L_HF + eb * 4096 + tid * 8));
        }
    }
    f32x4 ss = (f32x4){0.f, 0.f, 0.f, 0.f};
#pragma unroll
    for (int eb = 0; eb < 16; ++eb) ss += O[eb] * O[eb];
#pragma unroll
    for (int off = 1; off < 16; off <<= 1) { ss[0] += __shfl_xor(ss[0], off); ss[1] += __shfl_xor(ss[1], off); ss[2] += __shfl_xor(ss[2], off); ss[3] += __shfl_xor(ss[3], off); }
    f32x4 rr;
#pragma unroll
    for (int r = 0; r < 4; ++r) rr[r] = 1.f / sqrtf(ss[r] * (1.f / 256.f) + EPS);
#pragma unroll
    for (int eb = 0; eb < 16; ++eb) { const int col = h * 256 + 16 * eb + q; const float gg = gm[col];
#pragma unroll
        for (int r = 0; r < 4; ++r) { const size_t i = (size_t)(arow0 + r) * 1024 + col; QM[i] = f2bf(O[eb][r] * rr[r] * gg * bf2f(OM[i])); }
        if ((eb & 1) == 1) __builtin_amdgcn_sched_barrier(0); }
}
}
__global__ void __launch_bounds__(512, 2) k_hunit(bf16_t* QM, const bf16_t* KM, const bf16_t* VT, const bf16_t* OM, const bf16_t* CT, const float* NT, const float* SC, const float* gm) {
    extern __shared__ __attribute__((aligned(16))) unsigned char lds_dyn[];
    const int G = gridDim.x, bx = blockIdx.x, vcu = (G % 8 == 0) ? (bx % 8) * (G / 8) + bx / 8 : bx;
    for (int u = vcu; u < 384; u += G) { hu::hunit(u, QM, KM, VT, OM, CT, NT, SC, gm, lds_dyn); __syncthreads(); }
}
__global__ void __launch_bounds__(256) k_wt(const float* __restrict__ W, bf16_t* __restrict__ WT, int ldw, int col0, int K, int drow0) {
    __shared__ float t[64][65];
    const int tid = threadIdx.x, n0 = blockIdx.x * 64, k0 = blockIdx.y * 64;
    for (int i = tid; i < 4096; i += 256) { const int kk = i >> 6, nn = i & 63; t[kk][nn] = W[(size_t)(k0 + kk) * ldw + col0 + n0 + nn]; }
    __syncthreads();
    for (int i = tid; i < 2048; i += 256) { const int nn = i >> 5, kp = (i & 31) * 2;
        const unsigned v = (unsigned)f2bf(t[kp][nn]) | ((unsigned)f2bf(t[kp + 1][nn]) << 16);
        *(unsigned*)(WT + (size_t)(drow0 + n0 + nn) * K + k0 + kp) = v; }
}
__global__ void k_qk_post2(bf16_t* __restrict__ X, const float* __restrict__ gain, float* __restrict__ ck_out, int nheads, int is_k) {
    const int gw = blockIdx.x * 4 + (threadIdx.x >> 6), lane = threadIdx.x & 63;
    const int row = gw / nheads, head = gw % nheads; if (row >= MTOK) return;
    const int b = row < NCTX ? 0 : (row - NCTX) >> 12, tt = (row - NCTX) & 4095;
    const size_t xrow = (is_k && row >= NCTX) ? (size_t)(NCTX + b * KV_ROWS_LAT + tt) : (size_t)row;
    bf16_t* t = X + xrow * (nheads * 128) + head * 128;
    const int axis = lane >> 5, f = lane & 31, d0 = axis * 64 + f, d1 = d0 + 32;
    float x0 = bf2f(t[d0]), x1 = bf2f(t[d1]);
    const float ss = wave_sum(x0 * x0 + x1 * x1);
    const float r = 1.f / sqrtf(ss * (1.f / 128.f) + EPS);
    x0 = x0 * r * gain[d0]; x1 = x1 * r * gain[d1];
    if (row < NCTX) {
        if (is_k) { ck_out[(size_t)row * 256 + head * 128 + d0] = x0; ck_out[(size_t)row * 256 + head * 128 + d1] = x1; }
    } else {
        const float pos = (float)(axis == 0 ? (tt >> 6) : (tt & 63));
        const float inv = powf(10000.f, -(float)f / 32.f);
        const float ang = pos * inv, cs = cosf(ang), sn = sinf(ang);
        const float y0 = x0 * cs - x1 * sn, y1 = x1 * cs + x0 * sn; x0 = y0; x1 = y1;
    }
    t[d0] = f2bf(x0); t[d1] = f2bf(x1);
}

template <class Epi> static void gemm(hipStream_t st, const bf16_t* A, int lda, const float* B, int ldb, int boff, int M, int N, int K, Epi E) {
    hipLaunchKernelGGL((k_gemm<Epi>), dim3(N / 64, M / 64), dim3(256), 0, st, A, B, lda, ldb, boff, K, E);
}
template <class Epi> static void fgemm(hipStream_t st, const bf16_t* A, int lda, const bf16_t* Bt, int ldb, int M, int N, int K, Epi E) {
    static bool attr = false;
    if (!attr) { if (hipFuncSetAttribute((const void*)k_fgemm<Epi>, hipFuncAttributeMaxDynamicSharedMemorySize, FG_LDS) != hipSuccess) fprintf(stderr, "hipFuncSetAttribute failed\n"); attr = true; }
    pg8::Gemm g{A, Bt, M, N, K, lda, ldb, 0};
    hipLaunchKernelGGL((k_fgemm<Epi>), dim3(256), dim3(512), FG_LDS, st, g, E);
}
static void wt(hipStream_t st, const float* W, int ldw, int col0, int ncols, int K, bf16_t* WT, int drow0) {
    hipLaunchKernelGGL(k_wt, dim3(ncols / 64, K / 64), dim3(256), 0, st, W, WT, ldw, col0, K, drow0);
}
extern "C" void kernel_launch(void* const* d_in, const int* in_sizes, int n_in, void* d_out, int out_size, void* d_ws, size_t ws_size, hipStream_t stream) {
    const float* x_prompt = (const float*)d_in[0]; const float* x_sample = (const float*)d_in[1];
    const float* cache_k = (const float*)d_in[2]; const float* cache_v = (const float*)d_in[3];
    const float* state_C = (const float*)d_in[4]; const float* state_n = (const float*)d_in[5]; const float* state_m = (const float*)d_in[6];
    const float* c = (const float*)d_in[7]; const float* c_ctx = (const float*)d_in[8];
    const float* w_mod = (const float*)d_in[9]; const float* b_mod = (const float*)d_in[10]; const float* w_in = (const float*)d_in[11]; const float* b_gates = (const float*)d_in[12];
    const float* mlstm_g = (const float*)d_in[13]; const float* q_g = (const float*)d_in[14]; const float* k_g = (const float*)d_in[15];
    const float* w_bm = (const float*)d_in[16]; const float* w_ba = (const float*)d_in[17]; const float* w_out = (const float*)d_in[18];
    const float* ln1_g = (const float*)d_in[19]; const float* ln1_b = (const float*)d_in[20]; const float* w_up = (const float*)d_in[21]; const float* w_down = (const float*)d_in[22];
    const float* ln2_g = (const float*)d_in[23]; const float* ln2_b = (const float*)d_in[24];
    float* out = (float*)d_out; unsigned char* ws = (unsigned char*)d_ws;
    float* MOD = (float*)(ws + WS_MOD); float* CH = (float*)(ws + WS_CH); float* UN = (float*)(ws + WS_UN); float* GATES = (float*)(ws + WS_GATES); float* SC = (float*)(ws + WS_SC);
    bf16_t* HB = (bf16_t*)(ws + WS_HB); bf16_t* QM = (bf16_t*)(ws + WS_QM); bf16_t* QA = (bf16_t*)(ws + WS_QA); bf16_t* KA = (bf16_t*)(ws + WS_KA); bf16_t* VA = (bf16_t*)(ws + WS_VA);
    bf16_t* KM = (bf16_t*)(ws + WS_KM); bf16_t* OM = (bf16_t*)(ws + WS_OM); bf16_t* VT = (bf16_t*)(ws + WS_VT); bf16_t* KT = (bf16_t*)(ws + WS_KFT);
    bf16_t* WinT = (bf16_t*)(ws + WS_WIN); bf16_t* WbmT = (bf16_t*)(ws + WS_WBM); bf16_t* WbaT = (bf16_t*)(ws + WS_WBA); bf16_t* WoutT = (bf16_t*)(ws + WS_WOUT);
    bf16_t* WupT = (bf16_t*)(ws + WS_WUP); bf16_t* WdownT = (bf16_t*)(ws + WS_WDN);
    float* Y = out + O_Y;
    wt(stream, w_in, DIN, C_QM, 1024, DM, WinT, R_QM); wt(stream, w_in, DIN, C_OM, 1024, DM, WinT, R_OM); wt(stream, w_in, DIN, C_QA, 1536, DM, WinT, R_QA);
    wt(stream, w_in, DIN, C_KM, 2048, DM, WinT, R_KM); wt(stream, w_in, DIN, C_GM, 2048, DM, WinT, R_GM);
    wt(stream, w_bm, DM, 0, DM, DM, WbmT, 0); wt(stream, w_ba, DM, 0, DM, DM, WbaT, 0); wt(stream, w_out, DM, 0, DM, DM, WoutT, 0);
    wt(stream, w_up, DFF, 0, DFF, DM, WupT, 0); wt(stream, w_down, DM, 0, DM, DFF, WdownT, 0);
    hipLaunchKernelGGL(k_mod, dim3(3 * 6144 / 256), dim3(256), 0, stream, c, c_ctx, w_mod, b_mod, MOD);
    hipLaunchKernelGGL(k_cache, dim3(2 * 256 * 256 / 256), dim3(256), 0, stream, cache_k, cache_v, KA, VA);
    hipLaunchKernelGGL(k_hgates, dim3(MTOK / 4), dim3(256), 0, stream, x_prompt, x_sample, MOD, w_in, b_gates, HB, GATES);
    hipLaunchKernelGGL(k_scan, dim3(144), dim3(64), 0, stream, GATES, state_m, SC, CH, out + O_SM);
    fgemm(stream, HB, DM, WinT, DM, MTOK, 4608, DM, pg8::EpiProj{QM, OM, QA, KA, VA, KM, KM, OM, out + O_CV, 0, 0});
    fgemm(stream, WinT + (size_t)R_KM * DM, DM, HB, DM, 2048, MTOK, DM, pg8::EpiKVT{KT, VT, SC + SC_WU * SC_STRIDE});
    hipLaunchKernelGGL(k_qk_post2, dim3(MTOK * 8 / 4), dim3(256), 0, stream, QA, q_g, (float*)nullptr, 8, 0);
    hipLaunchKernelGGL(k_qk_post2, dim3(MTOK * 2 / 4), dim3(256), 0, stream, KA, k_g, out + O_CK, 2, 1);
    bf16_t* HA = QA;
    { static bool attr = false; if (!attr) { (void)hipFuncSetAttribute((const void*)k_fattn, hipFuncAttributeMaxDynamicSharedMemorySize, FG_LDS); attr = true; } }
    hipLaunchKernelGGL(k_fattn, dim3(256), dim3(512), FG_LDS, stream, QA, KA, VA);
    bf16_t* UT = (bf16_t*)Y; bf16_t* CT = KT; float* NT = (float*)(ws + WS_NT);
    hipLaunchKernelGGL(k_un, dim3(368), dim3(256), 0, stream, KT, CH, out + O_SN, UN);
    { static bool attr = false; if (!attr) { (void)hipFuncSetAttribute((const void*)k_ugemm<pg8::EpiUctx>, hipFuncAttributeMaxDynamicSharedMemorySize, FG_LDS);
                                             (void)hipFuncSetAttribute((const void*)k_ugemm<pg8::EpiUlat>, hipFuncAttributeMaxDynamicSharedMemorySize, FG_LDS);
                                             (void)hipFuncSetAttribute((const void*)k_hunit, hipFuncAttributeMaxDynamicSharedMemorySize, FG_LDS); attr = true; }
      pg8::Gemm g0{KT, VT, 256, 256, 256, MTOK, MTOK, 0}; pg8::Gemm g1{VT, KT, 256, 256, 256, MTOK, MTOK, 0};
      hipLaunchKernelGGL((k_ugemm<pg8::EpiUctx>), dim3(256), dim3(512), FG_LDS, stream, g0, pg8::EpiUctx{out + O_SC, CH + CH_BETAC}, 0, 0);
      hipLaunchKernelGGL((k_ugemm<pg8::EpiUlat>), dim3(256), dim3(512), FG_LDS, stream, g1, pg8::EpiUlat{UT}, 1, 0); }
    hipLaunchKernelGGL(k_cscan, dim3(256), dim3(512), 0, stream, state_C, state_n, UT, UN, CH, CT, NT);
    hipLaunchKernelGGL(k_hunit, dim3(256), dim3(512), FG_LDS, stream, QM, KM, VT, OM, CT, NT, SC, mlstm_g);
    bf16_t* HM = QM;
    bf16_t* GM = KM; bf16_t* GA = OM; float* Y1 = (float*)(ws + WS_KFT); bf16_t* MERGED = VT; bf16_t* H2 = HB;
    fgemm(stream, HB, DM, WinT + (size_t)R_GM * DM, DM, MTOK, 2048, DM, pg8::EpiSig2{GM, GA});
    fgemm(stream, HM, DM, WbmT, DM, MTOK, DM, DM, pg8::EpiStoreF32{Y1, DM, 0});
    fgemm(stream, HA, DM, WbaT, DM, MTOK, DM, DM, pg8::EpiMergeF{Y1, GM, GA, MERGED});
    fgemm(stream, MERGED, DM, WoutT, DM, MTOK, DM, DM, pg8::EpiResidXF{x_prompt, x_sample, MOD, Y, 2048, 0});
    hipLaunchKernelGGL(k_ln, dim3(MTOK / 4), dim3(256), 0, stream, Y, ln1_g, ln1_b, MOD, H2);
    bf16_t* FF = (bf16_t*)(ws + WS_KM);
    fgemm(stream, H2, DM, WupT, DM, MTOK, DFF, DM, pg8::EpiRelu2F{FF, DFF, 0});
    fgemm(stream, FF, DFF, WdownT, DFF, MTOK, DM, DFF, pg8::EpiResidInF{MOD, Y, 5120, 0});
    hipLaunchKernelGGL(k_ln, dim3(MTOK / 4), dim3(256), 0, stream, Y, ln2_g, ln2_b, MOD, (bf16_t*)nullptr);
}
```

```cpp
#include <hip/hip_runtime.h>
#include <cstdint>
#include <cstdio>

typedef unsigned short bf16_t;
typedef float f32x4 __attribute__((ext_vector_type(4)));

constexpr int DM = 1024, NCTX = 4096, NLAT = 8192, MTOK = NCTX + NLAT, DIN = 7696, DFF = 4096;
constexpr int TCTX = 256, TLAT = 4096, PAST = 256, NSEQ_CTX = 16, NSEQ_LAT = 2;
constexpr int KV_ROWS_LAT = TLAT + PAST;
constexpr int KV_ROWS = NCTX + NSEQ_LAT * KV_ROWS_LAT;
constexpr float EPS = 1e-6f;
constexpr float ALPHA = 1.189207115002721f;
constexpr int C_QM = 0, C_KM = 1024, C_VM = 2048, C_OM = 3072, C_GATES = 4096, C_QA = 4112, C_KA = 5136, C_VA = 5392, C_GM = 5648, C_GA = 6672;
constexpr size_t O_Y = 0, O_CK = (size_t)MTOK * DM, O_CV = O_CK + 1048576, O_SC = O_CV + 1048576, O_SN = O_SC + 8388608, O_SM = O_SN + 32768;
constexpr size_t MiB = 1u << 20;
constexpr size_t WS_MOD = 0, WS_CH = 128 * 1024, WS_UN = 256 * 1024, WS_NT = 512 * 1024, WS_GATES = 1 * MiB, WS_SC = 2 * MiB, WS_HB = 4 * MiB, WS_QM = 28 * MiB, WS_QA = 52 * MiB,
                 WS_KA = 76 * MiB, WS_VA = 83 * MiB, WS_KM = 90 * MiB, WS_OM = 114 * MiB, WS_VT = 138 * MiB, WS_KFT = 162 * MiB, WS_KBT = 186 * MiB,
                 WS_WIN = 210 * MiB, WS_WBM = 225 * MiB, WS_WBA = 227 * MiB, WS_WOUT = 229 * MiB, WS_WUP = 231 * MiB, WS_WDN = 239 * MiB;
constexpr int R_QM = 0, R_OM = 1024, R_QA = 2048, R_KA = 3072, R_VA = 3328, R_KM = 3584, R_VM = 4608, R_GM = 5632, R_GA = 6656;
constexpr int SC_A = 0, SC_M = 1, SC_WU = 2, SC_WI = 3, SC_FL = 4; constexpr size_t SC_STRIDE = (size_t)8 * MTOK;
constexpr int CH_ALPHA = 0, CH_BETA = 256, CH_BETAC = 512;

__device__ __forceinline__ bf16_t f2bf(float f) { unsigned u = __float_as_uint(f); u += 0x7fffu + ((u >> 16) & 1u); return (bf16_t)(u >> 16); }
__device__ __forceinline__ float bf2f(bf16_t b) { return __uint_as_float(((unsigned)b) << 16); }
__device__ __forceinline__ float sigmoidf_(float x) { return 1.f / (1.f + expf(-x)); }
__device__ __forceinline__ float shx(float v, int o, int lane) { return __int_as_float(__builtin_amdgcn_ds_bpermute((lane ^ o) << 2, __float_as_int(v))); }
__device__ __forceinline__ float shup(float v, int d, int lane) { return __int_as_float(__builtin_amdgcn_ds_bpermute((lane - d) << 2, __float_as_int(v))); }
__device__ __forceinline__ float rdlane63(float v) { return __int_as_float(__builtin_amdgcn_readlane(__float_as_int(v), 63)); }
__device__ __forceinline__ float wave_sum(float v, int lane) {
#pragma unroll
    for (int o = 1; o < 64; o <<= 1) v += shx(v, o, lane);
    return v;
}
__device__ __forceinline__ int otid(int wv) { int l; asm volatile("v_mbcnt_lo_u32_b32 %0, -1, 0\n\tv_mbcnt_hi_u32_b32 %0, -1, %0" : "=v"(l)); return wv * 64 + l; }
__device__ __forceinline__ int mod_index(int row) { return row < NCTX ? 0 : 1 + ((row - NCTX) >> 12); }
__device__ __forceinline__ const float* xrow_ptr(const float* xp, const float* xs, int row) { return row < NCTX ? xp + (size_t)row * DM : xs + (size_t)(row - NCTX) * DM; }

namespace pg8 {
#define PG8_LAS __attribute__((address_space(3)))
typedef unsigned short bf16_t;
typedef short bf16x8 __attribute__((ext_vector_type(8)));
typedef float f32x4 __attribute__((ext_vector_type(4)));
typedef unsigned u32x4 __attribute__((ext_vector_type(4)));
constexpr int BM = 256, BK = 64, HALF = 128, HTB = HALF * BK * 2  , STAGE_BYTES = 8 * HTB, NXCD = 8, WGM = 8;

__host__ __device__ __forceinline__ int lds_byte(int r, int c) { const int st = (r >> 4) * 2 + (c >> 5), rr = r & 15, cc = c & 31, ob = rr * 64 + cc * 2; return st * 1024 + (ob ^ (((ob >> 9) & 1) << 5)); }
__host__ __device__ __forceinline__ void stage_rc(int b, int& R, int& C) { const int st = b / 1024, sb = b % 1024, swz = sb ^ (((sb >> 9) & 1) << 5); R = (st >> 1) * 16 + swz / 64; C = (st & 1) * 32 + (swz % 64) / 2; }
__host__ __device__ __forceinline__ int perm32(int rho) { const int n = rho >> 4, i = rho & 15; return 8 * (i >> 2) + 4 * n + (i & 3); }

struct Unit { int pm, pn; };
__device__ __forceinline__ const char* uptr(const char* p) {
    const unsigned long long v = (unsigned long long)p; const unsigned lo = __builtin_amdgcn_readfirstlane((unsigned)v), hi = __builtin_amdgcn_readfirstlane((unsigned)(v >> 32));
    return (const char*)(((unsigned long long)hi << 32) | lo); }
struct Gemm { const bf16_t* A; const bf16_t* Bt; int M, N, K, lda, ldb, pad; };

struct StaticOrder {
    int nM, nN, nwg, G, c; size_t ta, tb;
    __host__ __device__ void init(int M, int N, int G_, int c_, int lda, int ldb) { nM = M / BM; nN = N / BM; nwg = nM * nN; G = G_; c = c_; ta = (size_t)BM * lda * 2; tb = (size_t)BM * ldb * 2; }
    __device__ __forceinline__ size_t a_off(const Unit& u) const { return (size_t)u.pm * ta; }
    __device__ __forceinline__ size_t b_off(const Unit& u) const { return (size_t)u.pn * tb; }
    __host__ __device__ bool next(int i, Unit& u) const {
        const long L = (long)i * G + c; if (L >= nwg) return false;
        int wgid = (int)L; { const int q = nwg / NXCD, r = nwg % NXCD, xcd = wgid % NXCD, off = wgid / NXCD; wgid = (xcd < r ? xcd * (q + 1) : r * (q + 1) + (xcd - r) * q) + off; }
        const int nig = WGM * nN, gid = wgid / nig, fm = gid * WGM, gsz = (nM - fm) < WGM ? (nM - fm) : WGM;
        u.pm = fm + ((wgid % nig) % gsz); u.pn = (wgid % nig) / gsz; return true;
    }
    __device__ __forceinline__ void a_ready(const Unit&) const {}
    __device__ __forceinline__ void done(const Unit&) const {}
};


typedef unsigned u32x2 __attribute__((ext_vector_type(2)));
__device__ __forceinline__ float fsig(float x) { return __builtin_amdgcn_rcpf(1.f + __builtin_amdgcn_exp2f(-1.4426950408889634f * x)); }
typedef float f32x2_t __attribute__((ext_vector_type(2))); typedef __bf16 bf16x2_t __attribute__((ext_vector_type(2)));
__device__ __forceinline__ unsigned cvt_pk_bf16(float lo, float hi) { f32x2_t v = {lo, hi}; bf16x2_t b = __builtin_convertvector(v, bf16x2_t); return __builtin_bit_cast(unsigned, b); }
__device__ __forceinline__ f32x4 bf4_to_f32(u32x2 w) { return (f32x4){__uint_as_float(w.x << 16), __uint_as_float(w.x & 0xffff0000u), __uint_as_float(w.y << 16), __uint_as_float(w.y & 0xffff0000u)}; }
struct EpiProj {
    static constexpr bool PERM = true, AFTER_DRAIN = false;
    bf16_t *QM, *OM, *QA, *KA, *VA, *KM, *GM, *GA; float* cv_out; int pn0, pad;
    __device__ __forceinline__ void operator()(const f32x4 (&acc)[2][2][4][2], const Unit& u, int wr, int wc, int fr, int fq) const {
        const int pn = u.pn + pn0; bf16_t* base; int ld = 1024, colt, act = 0; float sc = 1.f; bool kv = false;
        if (pn < 4) { base = QM; colt = pn * 256; }
        else if (pn < 8) { base = OM; colt = (pn - 4) * 256; act = 1; }
        else if (pn < 12) { base = QA; colt = (pn - 8) * 256; }
        else if (pn == 12) { base = KA; colt = 0; ld = 256; kv = true; }
        else if (pn == 13) { base = VA; colt = 0; ld = 256; kv = true; }
        else if (pn < 18) { base = KM; colt = (pn - 14) * 256; sc = 0.0625f; }
        else if (pn < 22) { base = GM; colt = (pn - 18) * 256; act = 1; }
        else { base = GA; colt = (pn - 22) * 256; act = 1; }
        const int row0 = u.pm * BM + wr * 64 + fr, radd = (kv && u.pm >= 16) ? ((u.pm - 16) >> 4) * 256 : 0, col0 = colt + wc * 32 + 8 * fq;
        const bool cvo = (pn == 13 && u.pm < 16);
#pragma unroll
        for (int ai = 0; ai < 2; ++ai)
#pragma unroll
            for (int m = 0; m < 4; ++m) { const int r = row0 + ai * HALF + m * 16; bf16_t* rowp = base + (size_t)(r + radd) * ld + col0;
#pragma unroll
                for (int bj = 0; bj < 2; ++bj) { f32x4 v0 = acc[ai][bj][m][0] * sc, v1 = acc[ai][bj][m][1] * sc;
                    if (act) {
#pragma unroll
                        for (int e = 0; e < 4; ++e) { v0[e] = fsig(v0[e]); v1[e] = fsig(v1[e]); } }
                    u32x4 w; w.x = cvt_pk_bf16(v0[0], v0[1]); w.y = cvt_pk_bf16(v0[2], v0[3]); w.z = cvt_pk_bf16(v1[0], v1[1]); w.w = cvt_pk_bf16(v1[2], v1[3]);
                    *(u32x4*)(rowp + bj * HALF) = w;
                    if (cvo) { float* cp = cv_out + (size_t)r * 256 + col0 + bj * HALF; *(f32x4*)cp = v0; *(f32x4*)(cp + 4) = v1; } } }
    }
};
struct EpiKVT {
    static constexpr bool PERM = true, AFTER_DRAIN = false;
    bf16_t* KT; bf16_t* VT; const float* wU;
    __device__ __forceinline__ void operator()(const f32x4 (&acc)[2][2][4][2], const Unit& u, int wr, int wc, int fr, int fq) const {
        const int head = u.pm & 3, tok0 = u.pn * BM + wc * 32 + 8 * fq; const bool isk = u.pm < 4;
        f32x4 wf[2][2], wb[2][2];
        if (isk) {
#pragma unroll
            for (int bj = 0; bj < 2; ++bj)
#pragma unroll
                for (int n = 0; n < 2; ++n) { wf[bj][n] = *(const f32x4*)(wU + (size_t)head * MTOK + tok0 + bj * HALF + 4 * n) * 0.0625f; wb[bj][n] = *(const f32x4*)(wU + (size_t)(4 + head) * MTOK + tok0 + bj * HALF + 4 * n) * 0.0625f; } }
#pragma unroll
        for (int ai = 0; ai < 2; ++ai)
#pragma unroll
            for (int m = 0; m < 4; ++m) { const int fl = head * 256 + ai * HALF + wr * 64 + m * 16 + fr;
#pragma unroll
                for (int bj = 0; bj < 2; ++bj) { const size_t o = (size_t)fl * MTOK + tok0 + bj * HALF; const f32x4 a0 = acc[ai][bj][m][0], a1 = acc[ai][bj][m][1];
                    if (isk) { f32x4 v0 = a0 * wf[bj][0], v1 = a1 * wf[bj][1]; u32x4 w; w.x = cvt_pk_bf16(v0[0], v0[1]); w.y = cvt_pk_bf16(v0[2], v0[3]); w.z = cvt_pk_bf16(v1[0], v1[1]); w.w = cvt_pk_bf16(v1[2], v1[3]); *(u32x4*)(KT + o) = w;
                        v0 = a0 * wb[bj][0]; v1 = a1 * wb[bj][1]; w.x = cvt_pk_bf16(v0[0], v0[1]); w.y = cvt_pk_bf16(v0[2], v0[3]); w.z = cvt_pk_bf16(v1[0], v1[1]); w.w = cvt_pk_bf16(v1[2], v1[3]); *(u32x4*)(KT + (size_t)1024 * MTOK + o) = w; }
                    else { u32x4 w; w.x = cvt_pk_bf16(a0[0], a0[1]); w.y = cvt_pk_bf16(a0[2], a0[3]); w.z = cvt_pk_bf16(a1[0], a1[1]); w.w = cvt_pk_bf16(a1[2], a1[3]); *(u32x4*)(VT + o) = w; } } }
    }
};
struct EpiSig2 {
    static constexpr bool PERM = true, AFTER_DRAIN = false; bf16_t* GM; bf16_t* GA;
    __device__ __forceinline__ void operator()(const f32x4 (&acc)[2][2][4][2], const Unit& u, int wr, int wc, int fr, int fq) const {
        bf16_t* base = u.pn < 4 ? GM : GA; const int row0 = u.pm * BM + wr * 64 + fr, col0 = (u.pn & 3) * 256 + wc * 32 + 8 * fq;
#pragma unroll
        for (int ai = 0; ai < 2; ++ai)
#pragma unroll
            for (int m = 0; m < 4; ++m) { bf16_t* rowp = base + (size_t)(row0 + ai * HALF + m * 16) * 1024 + col0;
#pragma unroll
                for (int bj = 0; bj < 2; ++bj) { f32x4 v0 = acc[ai][bj][m][0], v1 = acc[ai][bj][m][1];
#pragma unroll
                    for (int e = 0; e < 4; ++e) { v0[e] = fsig(v0[e]); v1[e] = fsig(v1[e]); }
                    u32x4 w; w.x = cvt_pk_bf16(v0[0], v0[1]); w.y = cvt_pk_bf16(v0[2], v0[3]); w.z = cvt_pk_bf16(v1[0], v1[1]); w.w = cvt_pk_bf16(v1[2], v1[3]);
                    *(u32x4*)(rowp + bj * HALF) = w; } }
    }
};
struct EpiUctx {
    static constexpr bool PERM = false, AFTER_DRAIN = false; float* oC; const float* betac;
    __device__ __forceinline__ void operator()(const f32x4 (&acc)[2][2][4][2], const Unit& u, int wr, int wc, int fr, int fq) const {
        const float beta = betac[u.pm]; float* ob = oC + (size_t)u.pm * 65536;
#pragma unroll
        for (int ai = 0; ai < 2; ++ai)
#pragma unroll
            for (int m = 0; m < 4; ++m) { float* rowp = ob + (size_t)(ai * HALF + wr * 64 + m * 16 + fr) * 256 + wc * 32 + 4 * fq;
#pragma unroll
                for (int bj = 0; bj < 2; ++bj)
#pragma unroll
                    for (int n = 0; n < 2; ++n) *(f32x4*)(rowp + bj * HALF + n * 16) = acc[ai][bj][m][n] * beta;
                asm volatile("" ::: "memory"); }
    }
};
struct EpiUlat {
    static constexpr bool PERM = true, AFTER_DRAIN = false; bf16_t* UT;
    __device__ __forceinline__ void operator()(const f32x4 (&acc)[2][2][4][2], const Unit& u, int wr, int wc, int fr, int fq) const {
        const int id = u.pm, b = id / 120, rem = id % 120, dirh = rem / 15, ci = rem % 15, c = (dirh >> 2) ? ci + 1 : ci;
        bf16_t* ob = UT + (size_t)((b * 8 + dirh) * 16 + c) * 65536;
#pragma unroll
        for (int ai = 0; ai < 2; ++ai)
#pragma unroll
            for (int m = 0; m < 4; ++m) { bf16_t* rowp = ob + (size_t)(ai * HALF + wr * 64 + m * 16 + fr) * 256 + wc * 32 + 8 * fq;
#pragma unroll
                for (int bj = 0; bj < 2; ++bj) { const f32x4 v0 = acc[ai][bj][m][0], v1 = acc[ai][bj][m][1];
                    u32x4 w; w.x = cvt_pk_bf16(v0[0], v0[1]); w.y = cvt_pk_bf16(v0[2], v0[3]); w.z = cvt_pk_bf16(v1[0], v1[1]); w.w = cvt_pk_bf16(v1[2], v1[3]);
                    *(u32x4*)(rowp + bj * HALF) = w; }
                asm volatile("" ::: "memory"); }
    }
};
struct UOrder {
    int G, c, mode, n;
    __device__ __forceinline__ void init(int G_, int c_, int mode_) { G = G_; c = c_; mode = mode_; n = mode_ ? 240 : 128; }
    __device__ __forceinline__ bool next(int i, Unit& u) const { const int L = i * G + c; if (L >= n) return false; u.pm = L; u.pn = L; return true; }
    __device__ __forceinline__ void offs(int id, size_t& ko, size_t& vo) const {
        int dirh, tok0;
        if (mode == 0) { dirh = id & 7; tok0 = (id >> 3) * 256; }
        else { const int b = id / 120, rem = id % 120, ci = rem % 15; dirh = rem / 15; tok0 = NCTX + b * TLAT + ((dirh >> 2) ? ci + 1 : ci) * 256; }
        const int dir = dirh >> 2, h = dirh & 3;
        ko = ((size_t)(dir * 1024 + h * 256) * MTOK + tok0) * 2; vo = ((size_t)(h * 256) * MTOK + tok0) * 2;
    }
    __device__ __forceinline__ size_t a_off(const Unit& u) const { size_t ko, vo; offs(u.pm, ko, vo); return mode == 0 ? ko : vo; }
    __device__ __forceinline__ size_t b_off(const Unit& u) const { size_t ko, vo; offs(u.pm, ko, vo); return mode == 0 ? vo : ko; }
    __device__ __forceinline__ void a_ready(const Unit&) const {}
    __device__ __forceinline__ void done(const Unit&) const {}
};
struct EpiStoreF32 {
    static constexpr bool PERM = false, AFTER_DRAIN = false; float* O; int ld, pad;
    __device__ __forceinline__ void operator()(const f32x4 (&acc)[2][2][4][2], const Unit& u, int wr, int wc, int fr, int fq) const {
        const int row0 = u.pm * BM + wr * 64 + fr, col0 = u.pn * BM + wc * 32 + 4 * fq;
#pragma unroll
        for (int ai = 0; ai < 2; ++ai)
#pragma unroll
            for (int m = 0; m < 4; ++m) { float* rowp = O + (size_t)(row0 + ai * HALF + m * 16) * ld + col0;
#pragma unroll
                for (int bj = 0; bj < 2; ++bj)
#pragma unroll
                    for (int n = 0; n < 2; ++n) *(f32x4*)(rowp + bj * HALF + n * 16) = acc[ai][bj][m][n]; }
    }
};
struct EpiMergeF {
    static constexpr bool PERM = false, AFTER_DRAIN = false; const float* Y1; const bf16_t* GM; const bf16_t* GA; bf16_t* O;
    __device__ __forceinline__ void operator()(const f32x4 (&acc)[2][2][4][2], const Unit& u, int wr, int wc, int fr, int fq) const {
        const int row0 = u.pm * BM + wr * 64 + fr, col0 = u.pn * BM + wc * 32 + 4 * fq;
#pragma unroll
        for (int ai = 0; ai < 2; ++ai)
#pragma unroll
            for (int m = 0; m < 4; ++m) { const size_t ro = (size_t)(row0 + ai * HALF + m * 16) * 1024 + col0;
#pragma unroll
                for (int bj = 0; bj < 2; ++bj)
#pragma unroll
                    for (int n = 0; n < 2; ++n) { const size_t i = ro + bj * HALF + n * 16;
                        const f32x4 y1 = *(const f32x4*)(Y1 + i), gm = bf4_to_f32(*(const u32x2*)(GM + i)), ga = bf4_to_f32(*(const u32x2*)(GA + i));
                        const f32x4 o = gm * y1 + ga * acc[ai][bj][m][n]; u32x2 w; w.x = cvt_pk_bf16(o[0], o[1]); w.y = cvt_pk_bf16(o[2], o[3]); *(u32x2*)(O + i) = w; } }
    }
};
struct EpiResidXF {
    static constexpr bool PERM = false, AFTER_DRAIN = false; const float* xp; const float* xs; const float* mod; float* O; int goff, pad;
    __device__ __forceinline__ void operator()(const f32x4 (&acc)[2][2][4][2], const Unit& u, int wr, int wc, int fr, int fq) const {
        const int row0 = u.pm * BM + wr * 64 + fr, col0 = u.pn * BM + wc * 32 + 4 * fq;
        const float* xb = u.pm < 16 ? xp : xs - (size_t)4096 * 1024; const float* md = mod + (u.pm < 16 ? 0 : 1 + ((u.pm - 16) >> 4)) * 6144 + goff;
#pragma unroll
        for (int ai = 0; ai < 2; ++ai)
#pragma unroll
            for (int m = 0; m < 4; ++m) { const size_t ro = (size_t)(row0 + ai * HALF + m * 16) * 1024 + col0;
#pragma unroll
                for (int bj = 0; bj < 2; ++bj)
#pragma unroll
                    for (int n = 0; n < 2; ++n) { const int c = col0 + bj * HALF + n * 16; const size_t i = ro + bj * HALF + n * 16;
                        *(f32x4*)(O + i) = *(const f32x4*)(xb + i) * 1.189207115002721f + *(const f32x4*)(md + c) * acc[ai][bj][m][n]; } }
    }
};
struct EpiResidInF {
    static constexpr bool PERM = false, AFTER_DRAIN = false; const float* mod; float* O; int goff, pad;
    __device__ __forceinline__ void operator()(const f32x4 (&acc)[2][2][4][2], const Unit& u, int wr, int wc, int fr, int fq) const {
        const int row0 = u.pm * BM + wr * 64 + fr, col0 = u.pn * BM + wc * 32 + 4 * fq;
        const float* md = mod + (u.pm < 16 ? 0 : 1 + ((u.pm - 16) >> 4)) * 6144 + goff;
#pragma unroll
        for (int ai = 0; ai < 2; ++ai)
#pragma unroll
            for (int m = 0; m < 4; ++m) { const size_t ro = (size_t)(row0 + ai * HALF + m * 16) * 1024 + col0;
#pragma unroll
                for (int bj = 0; bj < 2; ++bj)
#pragma unroll
                    for (int n = 0; n < 2; ++n) { const int c = col0 + bj * HALF + n * 16; const size_t i = ro + bj * HALF + n * 16;
                        *(f32x4*)(O + i) = *(const f32x4*)(O + i) * 1.189207115002721f + *(const f32x4*)(md + c) * acc[ai][bj][m][n]; } }
    }
};
struct EpiRelu2F {
    static constexpr bool PERM = true, AFTER_DRAIN = false; bf16_t* O; int ld, pad;
    __device__ __forceinline__ void operator()(const f32x4 (&acc)[2][2][4][2], const Unit& u, int wr, int wc, int fr, int fq) const {
        const int row0 = u.pm * BM + wr * 64 + fr, col0 = u.pn * BM + wc * 32 + 8 * fq;
#pragma unroll
        for (int ai = 0; ai < 2; ++ai)
#pragma unroll
            for (int m = 0; m < 4; ++m) { bf16_t* rowp = O + (size_t)(row0 + ai * HALF + m * 16) * ld + col0;
#pragma unroll
                for (int bj = 0; bj < 2; ++bj) { f32x4 v0 = acc[ai][bj][m][0], v1 = acc[ai][bj][m][1];
#pragma unroll
                    for (int e = 0; e < 4; ++e) { const float a = fmaxf(v0[e], 0.f), b = fmaxf(v1[e], 0.f); v0[e] = a * a; v1[e] = b * b; }
                    u32x4 w; w.x = cvt_pk_bf16(v0[0], v0[1]); w.y = cvt_pk_bf16(v0[2], v0[3]); w.z = cvt_pk_bf16(v1[0], v1[1]); w.w = cvt_pk_bf16(v1[2], v1[3]);
                    *(u32x4*)(rowp + bj * HALF) = w; } }
    }
};
template <class Epi, class Sched, bool ALIGN_EPI = false, bool SP2 = false>
__device__ __forceinline__ void gemm_phase(PG8_LAS unsigned char* lds, const Gemm g, const Sched& S, const Epi& E, int wv) {
    const int tid = otid(wv), wid = __builtin_amdgcn_readfirstlane(tid >> 6), lane = tid & 63, wr = wid >> 2, wc = wid & 3, fr = lane & 15, fq = lane >> 4;
    const int K = g.K, nt = K / BK;
    unsigned voffA[2], voffB[2];
#pragma unroll
    for (int i = 0; i < 2; ++i) { int R, C; stage_rc(tid * 16 + i * 8192, R, C); const int Rb = Epi::PERM ? ((R & ~31) + perm32(R & 31)) : R;
        voffA[i] = (unsigned)(R * g.lda + C) * 2u; voffB[i] = (unsigned)(Rb * g.ldb + C) * 2u; }
    const size_t kstep = (size_t)(BK * 2);
    const size_t hstepA = (size_t)HALF * g.lda * 2, hstepB = (size_t)HALF * g.ldb * 2;
    const unsigned ldsw = (unsigned)wid * 1024u;
    const int aoff = lds_byte(wr * 64 + fr, fq * 8), boff = lds_byte(wc * 32 + fr, fq * 8);
#define PG8_SA(b, h) (((b) * 2 + (h)) * HTB)
#define PG8_SB(b, h) ((4 + (b) * 2 + (h)) * HTB)
#define PG8_STAGE(bufoff, gbase, voff) do { _Pragma("unroll") for (int _i = 0; _i < 2; ++_i) \
        __builtin_amdgcn_global_load_lds((const unsigned*)((const char*)(gbase) + (voff)[_i]), (PG8_LAS unsigned*)(lds + (bufoff) + ldsw + _i * 8192), 16, 0, 0); } while (0)
#define PG8_LDA(dst, b, h) do { _Pragma("unroll") for (int m = 0; m < 4; ++m) _Pragma("unroll") for (int k = 0; k < 2; ++k) dst[m][k] = *(const PG8_LAS bf16x8*)(lds + PG8_SA(b, h) + aoff + m * 2048 + k * 1024); } while (0)
#define PG8_LDB(dst, b, h) do { _Pragma("unroll") for (int n = 0; n < 2; ++n) _Pragma("unroll") for (int k = 0; k < 2; ++k) dst[n][k] = *(const PG8_LAS bf16x8*)(lds + PG8_SB(b, h) + boff + n * 2048 + k * 1024); } while (0)
#define PG8_MMA(ai, bj, At, Bt) do { __builtin_amdgcn_s_setprio(1); _Pragma("unroll") for (int m = 0; m < 4; ++m) _Pragma("unroll") for (int n = 0; n < 2; ++n) _Pragma("unroll") for (int k = 0; k < 2; ++k) \
        acc[ai][bj][m][n] = __builtin_amdgcn_mfma_f32_16x16x32_bf16(Bt[n][k], At[m][k], acc[ai][bj][m][n], 0, 0, 0); __builtin_amdgcn_s_setprio(0); } while (0)
#define PG8_WAIT_V(n) asm volatile("s_waitcnt vmcnt(" #n ")" ::: "memory")
#define PG8_WAIT_L(n) asm volatile("s_waitcnt lgkmcnt(" #n ")" ::: "memory")
#define PG8_BAR __builtin_amdgcn_s_barrier()
#define PG8_SCHED __builtin_amdgcn_sched_barrier(0)
    Unit cur, nxt; int ui = 0;
    if (!S.next(0, cur)) return;
    f32x4 acc[2][2][4][2];
#pragma unroll
    for (int a = 0; a < 2; ++a)
#pragma unroll
        for (int b = 0; b < 2; ++b)
#pragma unroll
            for (int m = 0; m < 4; ++m)
#pragma unroll
                for (int n = 0; n < 2; ++n) acc[a][b][m][n] = (f32x4){0.f, 0.f, 0.f, 0.f};
    bf16x8 At[4][2], B0[2][2], B1[2][2];
    const char* cA = uptr((const char*)g.A + S.a_off(cur)); const char* cB = uptr((const char*)g.Bt + S.b_off(cur));
    S.a_ready(cur);
    if constexpr (SP2) {
        PG8_STAGE(PG8_SB(0, 0), cB, voffB); PG8_STAGE(PG8_SB(0, 1), cB + hstepB, voffB); PG8_STAGE(PG8_SA(0, 0), cA, voffA); PG8_STAGE(PG8_SA(0, 1), cA + hstepA, voffA);
        if (wr == 1) PG8_BAR;
        PG8_WAIT_V(2); PG8_BAR;
        PG8_STAGE(PG8_SB(1, 0), cB + kstep, voffB); PG8_STAGE(PG8_SA(1, 0), cA + kstep, voffA); PG8_STAGE(PG8_SB(1, 1), cB + hstepB + kstep, voffB);
        PG8_WAIT_V(6); PG8_BAR;
    } else {
        PG8_STAGE(PG8_SB(0, 0), cB, voffB); PG8_STAGE(PG8_SA(0, 0), cA, voffA); PG8_STAGE(PG8_SB(0, 1), cB + hstepB, voffB); PG8_STAGE(PG8_SA(0, 1), cA + hstepA, voffA);
        if (wr == 1) PG8_BAR;
        PG8_WAIT_V(4); PG8_BAR;
        PG8_STAGE(PG8_SB(1, 0), cB + kstep, voffB); PG8_STAGE(PG8_SA(1, 0), cA + kstep, voffA); PG8_STAGE(PG8_SB(1, 1), cB + hstepB + kstep, voffB);
        PG8_WAIT_V(6); PG8_BAR;
    }
    for (;;) {
        const bool has_next = S.next(ui + 1, nxt);
        const char* nA = uptr(has_next ? (const char*)g.A + S.a_off(nxt) : cA); const char* nB = uptr(has_next ? (const char*)g.Bt + S.b_off(nxt) : cB);
        for (int t = 0; t < nt; t += 2) {
            const bool last = (t == nt - 2);
            const char* a1 = cA + (size_t)(t + 1) * kstep;
            const char* a2 = last ? nA : cA + (size_t)(t + 2) * kstep; const char* b2 = last ? nB : cB + (size_t)(t + 2) * kstep;
            const char* a3 = a2 + kstep; const char* b3 = b2 + kstep;
            if (last && has_next) S.a_ready(nxt);
            if constexpr (SP2) {
            PG8_LDB(B0, 0, 0); PG8_LDB(B1, 0, 1); PG8_SCHED; PG8_LDA(At, 0, 0); PG8_STAGE(PG8_SA(1, 1), a1 + hstepA, voffA);
            PG8_WAIT_V(8); PG8_WAIT_L(0); PG8_BAR; PG8_MMA(0, 0, At, B0); PG8_MMA(0, 1, At, B1); PG8_BAR; PG8_SCHED;
            PG8_LDA(At, 0, 1); PG8_STAGE(PG8_SB(0, 0), b2, voffB); PG8_STAGE(PG8_SB(0, 1), b2 + hstepB, voffB); PG8_STAGE(PG8_SA(0, 0), a2, voffA);
            PG8_WAIT_V(8); PG8_WAIT_L(0); PG8_BAR; PG8_MMA(1, 0, At, B0); PG8_MMA(1, 1, At, B1); PG8_BAR; PG8_SCHED;
            PG8_LDB(B0, 1, 0); PG8_LDB(B1, 1, 1); PG8_SCHED; PG8_LDA(At, 1, 0); PG8_STAGE(PG8_SA(0, 1), a2 + hstepA, voffA);
            PG8_WAIT_V(8); PG8_WAIT_L(0); PG8_BAR; PG8_MMA(0, 0, At, B0); PG8_MMA(0, 1, At, B1); PG8_BAR; PG8_SCHED;
            PG8_LDA(At, 1, 1); PG8_STAGE(PG8_SB(1, 0), b3, voffB); PG8_STAGE(PG8_SB(1, 1), b3 + hstepB, voffB); PG8_STAGE(PG8_SA(1, 0), a3, voffA);
            PG8_WAIT_V(8); PG8_WAIT_L(0); PG8_BAR; PG8_MMA(1, 0, At, B0); PG8_MMA(1, 1, At, B1); PG8_BAR; PG8_SCHED;
            } else {
            PG8_LDB(B0, 0, 0); PG8_SCHED; PG8_LDA(At, 0, 0); PG8_STAGE(PG8_SA(1, 1), a1 + hstepA, voffA);
            PG8_WAIT_L(8); PG8_BAR; PG8_WAIT_L(0); PG8_MMA(0, 0, At, B0); PG8_BAR; PG8_SCHED;
            PG8_LDB(B1, 0, 1); PG8_STAGE(PG8_SB(0, 0), b2, voffB);
            PG8_BAR; PG8_WAIT_L(0); PG8_MMA(0, 1, At, B1); PG8_BAR;
            PG8_LDA(At, 0, 1); PG8_STAGE(PG8_SA(0, 0), a2, voffA);
            PG8_BAR; PG8_WAIT_L(0); PG8_MMA(1, 0, At, B0); PG8_BAR; PG8_SCHED;
            PG8_STAGE(PG8_SB(0, 1), b2 + hstepB, voffB);
            PG8_WAIT_V(6); PG8_BAR; PG8_MMA(1, 1, At, B1); PG8_BAR;
            PG8_LDB(B0, 1, 0); PG8_SCHED; PG8_LDA(At, 1, 0); PG8_STAGE(PG8_SA(0, 1), a2 + hstepA, voffA);
            PG8_WAIT_L(8); PG8_BAR; PG8_WAIT_L(0); PG8_MMA(0, 0, At, B0); PG8_BAR; PG8_SCHED;
            PG8_LDB(B1, 1, 1); PG8_STAGE(PG8_SB(1, 0), b3, voffB);
            PG8_BAR; PG8_WAIT_L(0); PG8_MMA(0, 1, At, B1); PG8_BAR;
            PG8_LDA(At, 1, 1); PG8_STAGE(PG8_SA(1, 0), a3, voffA);
            PG8_BAR; PG8_WAIT_L(0); PG8_MMA(1, 0, At, B0); PG8_BAR; PG8_SCHED;
            PG8_STAGE(PG8_SB(1, 1), b3 + hstepB, voffB);
            PG8_WAIT_V(6); PG8_BAR; PG8_MMA(1, 1, At, B1); PG8_BAR;
            }
        }
        if constexpr (ALIGN_EPI) { if (wr == 0) PG8_BAR; }
        if constexpr (!Epi::AFTER_DRAIN) { int fr_ = fr, fq_ = fq; asm volatile("" : "+v"(fr_), "+v"(fq_)); E(acc, cur, wr, wc, fr_, fq_); S.done(cur); }
        if (!has_next) break;
#pragma unroll
        for (int a = 0; a < 2; ++a)
#pragma unroll
            for (int b = 0; b < 2; ++b)
#pragma unroll
                for (int m = 0; m < 4; ++m)
#pragma unroll
                    for (int n = 0; n < 2; ++n) acc[a][b][m][n] = (f32x4){0.f, 0.f, 0.f, 0.f};
        cur = nxt; cA = nA; cB = nB; ++ui;
        if constexpr (ALIGN_EPI) { if (wr == 1) PG8_BAR; }
    }
    PG8_WAIT_V(0);
    if constexpr (!ALIGN_EPI) { if (wr == 0) PG8_BAR; }
    PG8_BAR;
    if constexpr (Epi::AFTER_DRAIN) { E.fused(acc, cur, wr, wc, fr, fq, lds, wid, lane); S.done(cur); }
#undef PG8_SA
#undef PG8_SB
#undef PG8_STAGE
#undef PG8_LDA
#undef PG8_LDB
#undef PG8_MMA
#undef PG8_WAIT_V
#undef PG8_WAIT_L
#undef PG8_BAR
#undef PG8_SCHED
}
}


namespace fa {
using bf16 = unsigned short;
constexpr int   D = 128, NW = 8, QBLK = 32, KVBLK = 64;
constexpr float SCALE = 0.088388347648318440f;
constexpr float THR = 8.f;
constexpr int SDEPTH = 1;
constexpr int LDQ = 1024, LDK = 256, LDO = 1024;
constexpr size_t SHM_V = KVBLK * D * 2, SHM_K = KVBLK * D * 2, SHM_ATTN = 2 * SHM_V + 2 * SHM_K + NW * 64 * 4;
using bf16x8 = __attribute__((ext_vector_type(8))) short;
using s16x4  = __attribute__((ext_vector_type(4))) short;
using f32x16 = __attribute__((ext_vector_type(16))) float;
using f32x8  = __attribute__((ext_vector_type(8))) float;
using u32x4  = __attribute__((ext_vector_type(4))) unsigned;
#define KSWZ(row, colB) ((row) * 256 + ((colB) ^ (((row) & 7) << 4)))
#define SBAR() __builtin_amdgcn_sched_barrier(0)
__device__ __forceinline__ int crow(int r, int hi) { return (r & 3) + 8 * (r >> 2) + 4 * hi; }
__device__ __forceinline__ unsigned cvtpk(float lo, float hi) {
  unsigned r; asm volatile("v_cvt_pk_bf16_f32 %0, %1, %2" : "=v"(r) : "v"(lo), "v"(hi)); return r;
}
template <typename TIn> struct Stage;
template <> struct Stage<bf16>  { using T = bf16x8;
  __device__ static __forceinline__ T ld8(const bf16* p) { return *reinterpret_cast<const bf16x8*>(p); }
  __device__ static __forceinline__ bf16x8 tobf(T x) { return x; } };
template <> struct Stage<float> { using T = f32x8;
  __device__ static __forceinline__ T ld8(const float* p) { return *reinterpret_cast<const f32x8*>(p); }
  __device__ static __forceinline__ bf16x8 tobf(T x) {
    u32x4 w = {cvtpk(x[0], x[1]), cvtpk(x[2], x[3]), cvtpk(x[4], x[5]), cvtpk(x[6], x[7])}; return *reinterpret_cast<bf16x8*>(&w); } };

__device__ __forceinline__ void partialSM(f32x16& p0, f32x16& p1, float& m_reg, float& mn, float& alpha) {
  constexpr float C = SCALE * 1.4426950408889634f;
  float pmax = p0[0]; for (int r = 1; r < 16; ++r) pmax = fmaxf(pmax, p0[r]); for (int r = 0; r < 16; ++r) pmax = fmaxf(pmax, p1[r]);
  { auto rr = __builtin_amdgcn_permlane32_swap(__float_as_uint(pmax), __float_as_uint(pmax), false, false);
    pmax = fmaxf(__uint_as_float(rr[0]), __uint_as_float(rr[1])); }
  if (__builtin_expect(__all(pmax - m_reg <= THR / SCALE), 1)) { mn = m_reg; alpha = 1.f; }
  else { mn = fmaxf(m_reg, pmax); alpha = __builtin_amdgcn_exp2f((m_reg - mn) * C); m_reg = mn; }
  float mnC = -mn * C;
  for (int r = 0; r < 16; ++r) p0[r] = fmaf(p0[r], C, mnC); for (int r = 0; r < 16; ++r) p1[r] = fmaf(p1[r], C, mnC);
  for (int r = 0; r < 16; ++r) p0[r] = __builtin_amdgcn_exp2f(p0[r]);
}
__device__ __forceinline__ void finishSM(f32x16& p0, f32x16& p1, float alpha, float& l_reg, bf16x8& pa0, bf16x8& pa1, bf16x8& pa2, bf16x8& pa3) {
  for (int r = 0; r < 16; ++r) p1[r] = __builtin_amdgcn_exp2f(p1[r]);
  float ps = 0; for (int r = 0; r < 16; ++r) ps += p0[r]; for (int r = 0; r < 16; ++r) ps += p1[r];
  { auto rr = __builtin_amdgcn_permlane32_swap(__float_as_uint(ps), __float_as_uint(ps), false, false);
    ps = __uint_as_float(rr[0]) + __uint_as_float(rr[1]); }
  l_reg = l_reg * alpha + ps;
#define PK4(P, BASE, OUT) do { unsigned a0 = cvtpk(P[BASE + 0], P[BASE + 1]), a1 = cvtpk(P[BASE + 2], P[BASE + 3]);   \
    unsigned b0 = cvtpk(P[BASE + 4], P[BASE + 5]), b1 = cvtpk(P[BASE + 6], P[BASE + 7]);                              \
    auto r0 = __builtin_amdgcn_permlane32_swap(a0, b0, false, false); auto r1 = __builtin_amdgcn_permlane32_swap(a1, b1, false, false); \
    u32x4 w = {r0[0], r1[0], r0[1], r1[1]}; OUT = *reinterpret_cast<bf16x8*>(&w); } while (0)
  PK4(p0, 0, pa0); PK4(p0, 8, pa1); PK4(p1, 0, pa2); PK4(p1, 8, pa3);
#undef PK4
}
__device__ __forceinline__ void qkt(f32x16& p0, f32x16& p1, const bf16* Ks, const bf16x8* qr, int r32, int hi) {
  p0 = f32x16{}; p1 = f32x16{};
  for (int d0 = 0; d0 < 8; ++d0) { int cb = (d0 * 16 + hi * 8) * 2;
    bf16x8 b0 = *reinterpret_cast<const bf16x8*>((const char*)Ks + KSWZ(r32, cb));
    bf16x8 b1 = *reinterpret_cast<const bf16x8*>((const char*)Ks + KSWZ(32 + r32, cb));
    p0 = __builtin_amdgcn_mfma_f32_32x32x16_bf16(b0, qr[d0], p0, 0, 0, 0);
    p1 = __builtin_amdgcn_mfma_f32_32x32x16_bf16(b1, qr[d0], p1, 0, 0, 0); }
}
__device__ __forceinline__ int v_st(int k, int c) { const int kk = (k & ~0xC) | ((k & 4) << 1) | ((k & 8) >> 1); return ((kk >> 3) * 4 + (c >> 5)) * 512 + ((kk & 7) * 32 + (c & 31)) * 2; }
__device__ __forceinline__ int v_rd_base(int lane) { return ((lane & 3) << 3) | (((lane >> 2) & 3) << 6) | (((lane >> 4) & 1) << 5) | (((lane >> 5) & 1) << 8); }
constexpr int v_rd_off(int d0, int ks, int half) { return d0 * 512 + ks * 4096 + half * 2048; }
template <int OFF> __device__ __forceinline__ s16x4 tr_read(int vb) {
  s16x4 r; asm volatile("ds_read_b64_tr_b16 %0, %1 offset:%2" : "=&v"(r) : "v"(vb), "i"(OFF) : "memory"); return r;
}
template <int D0> __device__ __forceinline__ void pv_one(f32x16& od, int vb, bf16x8 pa0, bf16x8 pa1, bf16x8 pa2, bf16x8 pa3) {
  const s16x4 l0 = tr_read<v_rd_off(D0, 0, 0)>(vb), h0 = tr_read<v_rd_off(D0, 0, 1)>(vb), l1 = tr_read<v_rd_off(D0, 1, 0)>(vb), h1 = tr_read<v_rd_off(D0, 1, 1)>(vb);
  const s16x4 l2 = tr_read<v_rd_off(D0, 2, 0)>(vb), h2 = tr_read<v_rd_off(D0, 2, 1)>(vb), l3 = tr_read<v_rd_off(D0, 3, 0)>(vb), h3 = tr_read<v_rd_off(D0, 3, 1)>(vb);
  asm volatile("s_waitcnt lgkmcnt(0)" ::: "memory"); SBAR();
#define PK(L, H) (bf16x8){L[0], L[1], L[2], L[3], H[0], H[1], H[2], H[3]}
  od = __builtin_amdgcn_mfma_f32_32x32x16_bf16(pa0, PK(l0, h0), od, 0, 0, 0);
  od = __builtin_amdgcn_mfma_f32_32x32x16_bf16(pa1, PK(l1, h1), od, 0, 0, 0);
  od = __builtin_amdgcn_mfma_f32_32x32x16_bf16(pa2, PK(l2, h2), od, 0, 0, 0);
  od = __builtin_amdgcn_mfma_f32_32x32x16_bf16(pa3, PK(l3, h3), od, 0, 0, 0);
#undef PK
}
__device__ __forceinline__ void pv_d0(f32x16* o, int vb, bf16x8 pa0, bf16x8 pa1, bf16x8 pa2, bf16x8 pa3) {
  pv_one<0>(o[0], vb, pa0, pa1, pa2, pa3); pv_one<1>(o[1], vb, pa0, pa1, pa2, pa3); pv_one<2>(o[2], vb, pa0, pa1, pa2, pa3); pv_one<3>(o[3], vb, pa0, pa1, pa2, pa3);
}

template <typename TQ>
__device__ __forceinline__ void attn_dense_body(const TQ* Qb, const bf16* __restrict__ Kh, const bf16* __restrict__ Vh,
                                                bf16* Ob, int seq, char* lds, int wv) {
  using St = Stage<bf16>; using SQ = Stage<TQ>;
  const int tid = otid(wv), wid = tid >> 6, lane = tid & 63, r32 = lane & 31, hi = lane >> 5;
  bf16* V_lds = (bf16*)lds; bf16* K_lds = (bf16*)(lds + 2 * SHM_V);
  float* ws = (float*)(lds + 2 * SHM_V + 2 * SHM_K) + wid * 64; float* li_l = ws; float* al_l = ws + 32;
  float m_reg = -1e30f, l_reg = 0; f32x16 o[4] = {}; bf16x8 qr[8];
  const TQ* Qw = Qb + (long)(wid * QBLK + r32) * LDQ + hi * 8;
#pragma unroll
  for (int d0 = 0; d0 < 8; ++d0) qr[d0] = SQ::tobf(SQ::ld8(Qw + d0 * 16));
  const int sr = tid >> 4, sc = (tid & 15) * 8, vst0 = v_st(sr, sc), vst1 = v_st(32 + sr, sc);
  const int vb0 = (int)(uintptr_t)V_lds + v_rd_base(lane);
  struct { typename St::T vs0, vs1, ks0, ks1; } sr_[SDEPTH];
#define SLOAD(i, k0) do { sr_[i].vs0 = St::ld8(&Vh[(long)((k0) + sr) * LDK + sc]); sr_[i].vs1 = St::ld8(&Vh[(long)((k0) + 32 + sr) * LDK + sc]); \
    sr_[i].ks0 = St::ld8(&Kh[(long)((k0) + sr) * LDK + sc]); sr_[i].ks1 = St::ld8(&Kh[(long)((k0) + 32 + sr) * LDK + sc]); } while (0)
#define SWRITE(b, i) do { *(bf16x8*)((char*)V_lds + (b) * SHM_V + vst0) = St::tobf(sr_[i].vs0);          \
    *(bf16x8*)((char*)V_lds + (b) * SHM_V + vst1) = St::tobf(sr_[i].vs1); int kc = sc * 2;               \
    *(bf16x8*)((char*)K_lds + (b) * SHM_K + KSWZ(sr, kc)) = St::tobf(sr_[i].ks0);                       \
    *(bf16x8*)((char*)K_lds + (b) * SHM_K + KSWZ(32 + sr, kc)) = St::tobf(sr_[i].ks1); } while (0)
#define SWAIT() do { if constexpr (SDEPTH == 2) asm volatile("s_waitcnt vmcnt(4)" ::: "memory"); else asm volatile("s_waitcnt vmcnt(0)" ::: "memory"); } while (0)
#define RESC(a) do { if (__any((a) < 1.f)) { if (hi == 0) al_l[r32] = (a); asm volatile("s_waitcnt lgkmcnt(0)" ::: "memory"); \
    for (int d = 0; d < 4; ++d) for (int r = 0; r < 16; ++r) o[d][r] *= al_l[crow(r, hi)]; } } while (0)
  f32x16 pA0, pA1, pB0, pB1; float mnA, mnB, alA, alB; bf16x8 pa0, pa1, pa2, pa3; const int NT = seq / KVBLK;
  constexpr int SE = 0, SO = SDEPTH - 1;
  SLOAD(SE, 0); asm volatile("s_waitcnt vmcnt(0)" ::: "memory"); SWRITE(0, SE); __syncthreads();
  qkt(pA0, pA1, K_lds, qr, r32, hi); partialSM(pA0, pA1, m_reg, mnA, alA);
  SLOAD(SO, KVBLK); if constexpr (SDEPTH == 2) { if (2 < NT) SLOAD(SE, 2 * KVBLK); }
  SWAIT(); SWRITE(1, SO); __syncthreads();
  for (int j = 1; j + 1 < NT; j += 2) {
    SBAR(); qkt(pB0, pB1, (bf16*)((char*)K_lds + SHM_K), qr, r32, hi);
    finishSM(pA0, pA1, alA, l_reg, pa0, pa1, pa2, pa3); SBAR();
    SLOAD(SO, (j + SDEPTH) * KVBLK); SBAR();
    pv_d0(o, vb0, pa0, pa1, pa2, pa3); partialSM(pB0, pB1, m_reg, mnB, alB);
    __syncthreads(); SWAIT(); SWRITE(0, SE);
    RESC(alB); __syncthreads();
    SBAR(); qkt(pA0, pA1, K_lds, qr, r32, hi);
    finishSM(pB0, pB1, alB, l_reg, pa0, pa1, pa2, pa3); SBAR();
    if (SDEPTH == 1 || j + 3 < NT) SLOAD(SE, (j + 1 + SDEPTH) * KVBLK); SBAR();
    pv_d0(o, vb0 + (int)SHM_V, pa0, pa1, pa2, pa3); partialSM(pA0, pA1, m_reg, mnA, alA);
    __syncthreads(); SWAIT(); SWRITE(1, SO);
    RESC(alA); __syncthreads();
  }
  SBAR(); qkt(pB0, pB1, (bf16*)((char*)K_lds + SHM_K), qr, r32, hi);
  finishSM(pA0, pA1, alA, l_reg, pa0, pa1, pa2, pa3); SBAR();
  pv_d0(o, vb0, pa0, pa1, pa2, pa3); partialSM(pB0, pB1, m_reg, mnB, alB);
  __syncthreads(); RESC(alB);
  finishSM(pB0, pB1, alB, l_reg, pa0, pa1, pa2, pa3); SBAR();
  pv_d0(o, vb0 + (int)SHM_V, pa0, pa1, pa2, pa3);
  if (hi == 0) li_l[r32] = l_reg; asm volatile("s_waitcnt lgkmcnt(0)" ::: "memory");
  float rli[16];
#pragma unroll
  for (int r = 0; r < 16; ++r) rli[r] = __builtin_amdgcn_rcpf(li_l[crow(r, hi)]);
  bf16* Ow = Ob + (long)(wid * QBLK) * LDO;
#pragma unroll
  for (int r = 0; r < 16; ++r) { int orow = crow(r, hi);
    for (int d0 = 0; d0 < 4; ++d0) Ow[(long)orow * LDO + d0 * 32 + r32] = f2bf(o[d0][r] * rli[r]); }
#undef SLOAD
#undef SWRITE
#undef SWAIT
#undef RESC
}

}

__device__ __forceinline__ void attn_phase(bf16_t* QA, const bf16_t* KA, const bf16_t* VA, char* lds, int vcu, int G, int wv) {
    for (int u = vcu; u < 384; u += G) {
        bf16_t* Q; const bf16_t* K; const bf16_t* V; int seq;
        if (u < 256) { const int grp = u >> 6, b = grp >> 1, kvh = grp & 1, g = (u >> 4) & 3, qb = u & 15, head = kvh * 4 + g;
            Q = QA + (size_t)(NCTX + b * TLAT + qb * 256) * 1024 + head * 128; const size_t ko = (size_t)(NCTX + b * KV_ROWS_LAT) * 256 + kvh * 128; K = KA + ko; V = VA + ko; seq = KV_ROWS_LAT; }
        else { const int c = u - 256, s = c >> 3, head = c & 7;
            Q = QA + (size_t)(s * 256) * 1024 + head * 128; const size_t ko = (size_t)(s * 256) * 256 + (head >> 2) * 128; K = KA + ko; V = VA + ko; seq = TCTX; }
        fa::attn_dense_body<fa::bf16>(Q, K, V, Q, seq, lds, wv);
        __syncthreads();
    }
}
namespace hu {
using pg8::bf16x8; using pg8::f32x4; using pg8::u32x4; using pg8::u32x2;
constexpr int KT_STRIDE = 528, BT_STRIDE = 144;
constexpr int L_KT = 0, L_BT = 64 * KT_STRIDE, L_A = L_BT + 256 * BT_STRIDE, L_N = L_A + 256, L_DEN = L_N + 1024, L_HF = L_DEN + 512, L_END = L_HF + 65536;
__device__ __forceinline__ void hunit(int u, bf16_t* QM, const bf16_t* __restrict__ KM, const bf16_t* __restrict__ VT, const bf16_t* __restrict__ OM, const bf16_t* __restrict__ CT,
                                      const float* __restrict__ NT, const float* __restrict__ SC, const float* __restrict__ gm, unsigned char* lds, int wv) {
    const int tid = otid(wv), lane = tid & 63, w = __builtin_amdgcn_readfirstlane(tid >> 6), q = lane & 15, g = lane >> 4;
    int h, blk, rowbase, chain0 = 0; bool lat;
    if (u < 256) { lat = true; const int b = u >> 7; h = (u >> 5) & 3; blk = u & 31; rowbase = NCTX + b * TLAT; chain0 = b * 8; }
    else { lat = false; const int c2 = u - 256; h = (c2 >> 1) & 3; blk = c2 & 1; rowbase = (c2 >> 3) * TCTX; }
    const int c = blk >> 1, half = blk & 1, cstart = rowbase + c * 256, R0 = cstart + half * 128, qrel = half * 128 + 16 * w + q;
    const int myrow = R0 + 16 * w + q;
    const int arow0 = R0 + 16 * w + 4 * g;
    bf16x8 qf[8];
#pragma unroll
    for (int s = 0; s < 8; ++s) qf[s] = *(const bf16x8*)(QM + (size_t)myrow * 1024 + h * 256 + 32 * s + 8 * g);
    f32x4 O[16];
    float* a_s = (float*)(lds + L_A); float* n_s = (float*)(lds + L_N); float* den_s = (float*)(lds + L_DEN) + w * 16;
#pragma unroll 1
    for (int dir = 0; dir < 2; ++dir) {
        const int dirh = dir * 4 + h; const size_t sco = (size_t)dirh * MTOK;
        const float Mq = SC[SC_M * SC_STRIDE + sco + myrow], flq = SC[SC_FL * SC_STRIDE + sco + myrow];
#pragma unroll
        for (int eb = 0; eb < 16; ++eb) O[eb] = (f32x4){0.f, 0.f, 0.f, 0.f};
        float den = 0.f;
        if (lat) {
            const size_t slot = (size_t)(chain0 + dirh) * 16 + c; const bf16_t* Cs = CT + slot * 65536;
#pragma unroll
            for (int ds = 0; ds < 4; ++ds) {
                { const bf16_t* cp = Cs + (tid >> 1) * 256 + (tid & 1) * 32 + 64 * ds; unsigned char* dp = lds + L_BT + (tid >> 1) * BT_STRIDE + (tid & 1) * 64;
#pragma unroll
                  for (int i = 0; i < 4; ++i) *(u32x4*)(dp + i * 16) = *(const u32x4*)(cp + i * 8); }
                if (ds == 0 && tid < 256) n_s[tid] = NT[slot * 256 + tid];
                __syncthreads();
#pragma unroll
                for (int eb = 0; eb < 16; ++eb)
#pragma unroll
                    for (int ks = 0; ks < 2; ++ks) { const bf16x8 B = *(const bf16x8*)(lds + L_BT + (16 * eb + q) * BT_STRIDE + (32 * ks + 8 * g) * 2);
                        O[eb] = __builtin_amdgcn_mfma_f32_16x16x32_bf16(qf[2 * ds + ks], B, O[eb], 0, 0, 0); if ((eb & 3) == 3 && ks == 1) __builtin_amdgcn_sched_barrier(0); }
                if (ds == 0) {
                    float dn = 0.f;
#pragma unroll
                    for (int s = 0; s < 8; ++s)
#pragma unroll
                        for (int j = 0; j < 8; ++j) dn += __uint_as_float(((unsigned)(unsigned short)qf[s][j]) << 16) * n_s[32 * s + 8 * g + j];
                    __builtin_amdgcn_sched_barrier(0);
                    dn += shx(dn, 16, lane); dn += shx(dn, 32, lane);
                    den = dn * SC[SC_WI * SC_STRIDE + sco + myrow];
                }
                __syncthreads();
            }
            const f32x4 wi = *(const f32x4*)(SC + SC_WI * SC_STRIDE + sco + arow0);
#pragma unroll
            for (int eb = 0; eb < 16; ++eb) O[eb] = O[eb] * wi;
        }
        const int jt0 = dir == 0 ? 0 : (half ? 2 : 0), jt1 = dir == 0 ? (half ? 3 : 1) : 3;
        float dsum = 0.f;
#pragma unroll 1
        for (int jt = jt0; jt <= jt1; ++jt) {
            const int KR0 = cstart + 64 * jt;
            { const bf16_t* kp = KM + (size_t)(KR0 + (tid >> 3)) * 1024 + h * 256 + (tid & 7) * 8; unsigned char* kd = lds + L_KT + (tid >> 3) * KT_STRIDE + (tid & 7) * 16;
              const bf16_t* vp = VT + (size_t)(h * 256 + (tid >> 1)) * MTOK + KR0 + (tid & 1) * 32; unsigned char* vd = lds + L_BT + (tid >> 1) * BT_STRIDE + (tid & 1) * 64;
#pragma unroll
              for (int i = 0; i < 4; ++i) { *(u32x4*)(kd + i * 128) = *(const u32x4*)(kp + i * 64); *(u32x4*)(vd + i * 16) = *(const u32x4*)(vp + i * 8); } }
            if (tid < 64) a_s[tid] = SC[SC_A * SC_STRIDE + sco + KR0 + tid];
            __syncthreads();
            const int rlo = half * 128 + 16 * w, rhi = rlo + 15, klo = 64 * jt, khi = klo + 63;
            const bool active = dir == 0 ? (klo <= rhi) : (khi >= rlo);
            if (active) {
                f32x4 st[4];
#pragma unroll
                for (int kb = 0; kb < 4; ++kb) { st[kb] = (f32x4){0.f, 0.f, 0.f, 0.f};
#pragma unroll
                    for (int s = 0; s < 8; ++s) { const bf16x8 A = *(const bf16x8*)(lds + L_KT + (16 * kb + q) * KT_STRIDE + (32 * s + 8 * g) * 2);
                        st[kb] = __builtin_amdgcn_mfma_f32_16x16x32_bf16(A, qf[s], st[kb], 0, 0, 0); } }
#pragma unroll
                for (int kb = 0; kb < 4; ++kb) { const f32x4 av = *(const f32x4*)(a_s + 16 * kb + 4 * g);
#pragma unroll
                    for (int r = 0; r < 4; ++r) { const int krel = klo + 16 * kb + 4 * g + r; const bool vis = dir == 0 ? (krel <= qrel) : (krel >= qrel);
                        const float p = vis ? st[kb][r] * __builtin_amdgcn_exp2f((av[r] - Mq) * 1.4426950408889634f) : 0.f; st[kb][r] = p; dsum += p; } }
#pragma unroll
                for (int s2 = 0; s2 < 2; ++s2) { u32x4 pw; pw.x = pg8::cvt_pk_bf16(st[2 * s2][0], st[2 * s2][1]); pw.y = pg8::cvt_pk_bf16(st[2 * s2][2], st[2 * s2][3]);
                    pw.z = pg8::cvt_pk_bf16(st[2 * s2 + 1][0], st[2 * s2 + 1][1]); pw.w = pg8::cvt_pk_bf16(st[2 * s2 + 1][2], st[2 * s2 + 1][3]);
                    const bf16x8 pa = __builtin_bit_cast(bf16x8, pw);
#pragma unroll
                    for (int eb = 0; eb < 16; ++eb) { const unsigned char* bp = lds + L_BT + (16 * eb + q) * BT_STRIDE + (32 * s2 + 4 * g) * 2;
                        const u32x2 lo = *(const u32x2*)bp, hi = *(const u32x2*)(bp + 32); u32x4 bw; bw.x = lo.x; bw.y = lo.y; bw.z = hi.x; bw.w = hi.y;
                        O[eb] = __builtin_amdgcn_mfma_f32_16x16x32_bf16(pa, __builtin_bit_cast(bf16x8, bw), O[eb], 0, 0, 0); if ((eb & 3) == 3) __builtin_amdgcn_sched_barrier(0); } }
            }
            __syncthreads();
        }
        dsum += shx(dsum, 16, lane); dsum += shx(dsum, 32, lane);
        den += dsum;
        if (g == 0) den_s[q] = 1.f / fmaxf(fabsf(den), flq);
        __syncthreads();
        const f32x4 rinv = *(const f32x4*)(den_s + 4 * g);
        __syncthreads();
        if (dir == 0) {
#pragma unroll
            for (int eb = 0; eb < 16; ++eb) { const f32x4 v = O[eb] * rinv; u32x2 pk; pk.x = pg8::cvt_pk_bf16(v[0], v[1]); pk.y = pg8::cvt_pk_bf16(v[2], v[3]); *(u32x2*)(lds + L_HF + eb * 4096 + tid * 8) = pk; }
        } else {
#pragma unroll
            for (int eb = 0; eb < 16; ++eb) O[eb] = O[eb] * rinv + pg8::bf4_to_f32(*(const u32x2*)(lds + L_HF + eb * 4096 + tid * 8));
        }
    }
    f32x4 ss = (f32x4){0.f, 0.f, 0.f, 0.f};
#pragma unroll
    for (int eb = 0; eb < 16; ++eb) ss += O[eb] * O[eb];
#pragma unroll
    for (int off = 1; off < 16; off <<= 1) { ss[0] += shx(ss[0], off, lane); ss[1] += shx(ss[1], off, lane); ss[2] += shx(ss[2], off, lane); ss[3] += shx(ss[3], off, lane); }
    f32x4 rr;
#pragma unroll
    for (int r = 0; r < 4; ++r) rr[r] = 1.f / sqrtf(ss[r] * (1.f / 256.f) + EPS);
#pragma unroll
    for (int eb = 0; eb < 16; ++eb) { const int col = h * 256 + 16 * eb + q; const float gg = gm[col];
#pragma unroll
        for (int r = 0; r < 4; ++r) { const size_t i = (size_t)(arow0 + r) * 1024 + col; QM[i] = f2bf(O[eb][r] * rr[r] * gg * bf2f(OM[i])); }
        if ((eb & 1) == 1) __builtin_amdgcn_sched_barrier(0); }
}
}

struct P {
    const float *x_prompt, *x_sample, *cache_k, *cache_v, *state_C, *state_n, *state_m, *c, *c_ctx, *w_mod, *b_mod, *w_in, *b_gates, *mlstm_g, *q_g, *k_g,
                *w_bm, *w_ba, *w_out, *ln1_g, *ln1_b, *w_up, *w_down, *ln2_g, *ln2_b;
    float* out; unsigned char* ws;
};
__device__ __forceinline__ void wt_tile(const float* __restrict__ W, bf16_t* __restrict__ WT, int ldw, int col0, int K, int drow0, int nt, int kt, float* t, int wv) {
    const int tid = otid(wv), n0 = nt * 64, k0 = kt * 64;
    for (int i = tid; i < 4096; i += 512) { const int kk = i >> 6, nn = i & 63; t[kk * 65 + nn] = W[(size_t)(k0 + kk) * ldw + col0 + n0 + nn]; }
    __syncthreads();
    for (int i = tid; i < 2048; i += 512) { const int nn = i >> 5, kp = (i & 31) * 2;
        const unsigned v = (unsigned)f2bf(t[kp * 65 + nn]) | ((unsigned)f2bf(t[(kp + 1) * 65 + nn]) << 16);
        *(unsigned*)(WT + (size_t)(drow0 + n0 + nn) * K + k0 + kp) = v; }
    __syncthreads();
}
__device__ __forceinline__ void ph_weights(const float* w_in, const float* w_bm, const float* w_ba, const float* w_out, const float* w_up, const float* w_down, unsigned char* ws, unsigned char* lds, int bx, int G, int wv) {
    bf16_t* WinT = (bf16_t*)(ws + WS_WIN); float* t = (float*)lds;
    for (int it = bx; it < 4736; it += G) {
        int r = it;
        if (r < 256) { wt_tile(w_in, WinT, DIN, C_QM, DM, R_QM, r & 15, r >> 4, t, wv); continue; } r -= 256;
        if (r < 256) { wt_tile(w_in, WinT, DIN, C_OM, DM, R_OM, r & 15, r >> 4, t, wv); continue; } r -= 256;
        if (r < 384) { wt_tile(w_in, WinT, DIN, C_QA, DM, R_QA, r % 24, r / 24, t, wv); continue; } r -= 384;
        if (r < 512) { wt_tile(w_in, WinT, DIN, C_KM, DM, R_KM, r & 31, r >> 5, t, wv); continue; } r -= 512;
        if (r < 512) { wt_tile(w_in, WinT, DIN, C_GM, DM, R_GM, r & 31, r >> 5, t, wv); continue; } r -= 512;
        if (r < 256) { wt_tile(w_bm, (bf16_t*)(ws + WS_WBM), DM, 0, DM, 0, r & 15, r >> 4, t, wv); continue; } r -= 256;
        if (r < 256) { wt_tile(w_ba, (bf16_t*)(ws + WS_WBA), DM, 0, DM, 0, r & 15, r >> 4, t, wv); continue; } r -= 256;
        if (r < 256) { wt_tile(w_out, (bf16_t*)(ws + WS_WOUT), DM, 0, DM, 0, r & 15, r >> 4, t, wv); continue; } r -= 256;
        if (r < 1024) { wt_tile(w_up, (bf16_t*)(ws + WS_WUP), DFF, 0, DM, 0, r & 63, r >> 6, t, wv); continue; } r -= 1024;
        wt_tile(w_down, (bf16_t*)(ws + WS_WDN), DM, 0, DFF, 0, r & 15, r >> 4, t, wv);
    }
}
__device__ __forceinline__ void ph_mod(const float* __restrict__ c, const float* __restrict__ c_ctx, const float* __restrict__ w_mod, const float* __restrict__ b_mod, float* __restrict__ MOD, unsigned char* lds, int bx, int G, int wv) {
    const int tid = otid(wv), lane = tid & 63, w = tid >> 6; float* red = (float*)lds;
    for (int j = bx; j < 96; j += G) {
        const int n = j * 64 + lane; float a0 = 0.f, a1 = 0.f, a2 = 0.f;
        for (int k = w * 128; k < w * 128 + 128; ++k) { const float wv = w_mod[(size_t)k * 6144 + n];
            const float x0 = c_ctx[k], x1 = c[k], x2 = c[DM + k];
            a0 += x0 * sigmoidf_(x0) * wv; a1 += x1 * sigmoidf_(x1) * wv; a2 += x2 * sigmoidf_(x2) * wv; }
        red[(w * 3 + 0) * 64 + lane] = a0; red[(w * 3 + 1) * 64 + lane] = a1; red[(w * 3 + 2) * 64 + lane] = a2;
        __syncthreads();
        if (tid < 192) { const int r = tid >> 6; float sacc = 0.f;
#pragma unroll
            for (int ww = 0; ww < 8; ++ww) sacc += red[(ww * 3 + r) * 64 + lane];
            MOD[r * 6144 + n] = sacc + b_mod[n]; }
        __syncthreads();
    }
}
__device__ __forceinline__ void ph_cache(const float* __restrict__ cache_k, const float* __restrict__ cache_v, bf16_t* __restrict__ KA, bf16_t* __restrict__ VA, int bx, int G, int wv) {
    for (int idx = bx * 512 + otid(wv); idx < 2 * 256 * 256; idx += G * 512) { const int b = idx >> 16, j = (idx >> 8) & 255, col = idx & 255;
        const size_t dst = (size_t)(NCTX + b * KV_ROWS_LAT + TLAT + j) * 256 + col; KA[dst] = f2bf(cache_k[idx]); VA[dst] = f2bf(cache_v[idx]); }
}
__device__ __forceinline__ void ph_hgates(const float* __restrict__ x_prompt, const float* __restrict__ x_sample, const float* __restrict__ w_in, const float* __restrict__ b_gates, const float* __restrict__ MOD,
                                          bf16_t* __restrict__ HB, float* __restrict__ gates, unsigned char* lds, int bx, int G, int wv) {
    const int tid = otid(wv), lane = tid & 63, w = tid >> 6; float* Wg = (float*)lds;
    for (int idx = tid; idx < 16384; idx += 512) { const int k = idx >> 4, i = idx & 15; Wg[k * 20 + i] = w_in[(size_t)k * DIN + C_GATES + i]; }
    __syncthreads();
    for (int row = bx * 8 + w; row < MTOK; row += G * 8) {
        const float* x = xrow_ptr(x_prompt, x_sample, row); const float* md = MOD + mod_index(row) * 6144;
        f32x4 g0 = {0.f, 0.f, 0.f, 0.f}, g1 = g0, g2 = g0, g3 = g0;
#pragma unroll 4
        for (int i = 0; i < 16; ++i) { const int k = lane + 64 * i; const float hv = x[k] * (1.f + md[1024 + k]) + md[k];
            HB[(size_t)row * DM + k] = f2bf(hv); const f32x4* wr = (const f32x4*)(Wg + k * 20);
            g0 += wr[0] * hv; g1 += wr[1] * hv; g2 += wr[2] * hv; g3 += wr[3] * hv; }
        float gv[16] = {g0[0], g0[1], g0[2], g0[3], g1[0], g1[1], g1[2], g1[3], g2[0], g2[1], g2[2], g2[3], g3[0], g3[1], g3[2], g3[3]};
#pragma unroll
        for (int i = 0; i < 16; ++i) { const float sacc = wave_sum(gv[i], lane); if (lane == i) gates[(size_t)row * 16 + i] = sacc + b_gates[i]; }
    }
    __syncthreads();
}
__device__ __forceinline__ void ph_scan(const float* __restrict__ gates, const float* __restrict__ sM, float* __restrict__ SC, float* __restrict__ CH, float* __restrict__ oM, int bx, int G, int wv) {
    const int tid_ = otid(wv), lane = tid_ & 63;
    for (int chain = bx * 8 + (tid_ >> 6); chain < 144; chain += G * 8) {
    const bool ctx = chain < 128;

    int dirh, T, row0, b = 0; float m = 0.f;
    if (ctx) { dirh = chain & 7; T = TCTX; row0 = (chain >> 3) * TCTX; }
    else { const int cl = chain - 128; b = cl >> 3; dirh = cl & 7; T = TLAT; row0 = NCTX + b * TLAT; m = sM[b * 8 + dirh]; }
    const int dir = dirh >> 2, h = dirh & 3, nc = T / 256;
    for (int ci = 0; ci < nc; ++ci) {
        const int c = dir ? nc - 1 - ci : ci, tok0 = row0 + c * 256;
        float ig[4], lb[4], a[4], pm_[4]; int tok[4];
        float run = 0.f;
#pragma unroll
        for (int e = 0; e < 4; ++e) { const int p = 4 * lane + e; tok[e] = dir ? tok0 + 255 - p : tok0 + p;
            ig[e] = gates[(size_t)tok[e] * 16 + dir * 8 + h]; const float fp = gates[(size_t)tok[e] * 16 + dir * 8 + 4 + h];
            const float lf = fminf(fp, 0.f) - log1pf(expf(-fabsf(fp))); run += lf; lb[e] = run; }
        float incl = run;
#pragma unroll
        for (int off = 1; off < 64; off <<= 1) { const float v = shup(incl, off, lane); if (lane >= off) incl += v; }
        const float excl = incl - run, F = rdlane63(incl);
        float lm = -3.0e38f;
#pragma unroll
        for (int e = 0; e < 4; ++e) { lb[e] += excl; a[e] = ig[e] - lb[e]; lm = fmaxf(lm, a[e]); pm_[e] = lm; }
        float inm = lm;
#pragma unroll
        for (int off = 1; off < 64; off <<= 1) { const float v = shup(inm, off, lane); if (lane >= off) inm = fmaxf(inm, v); }
        float exm = shup(inm, 1, lane); if (lane == 0) exm = -3.0e38f;
        const float A = rdlane63(inm);
#pragma unroll
        for (int e = 0; e < 4; ++e) { const float M = fmaxf(m, fmaxf(exm, pm_[e])); const size_t idx = (size_t)dirh * MTOK + tok[e];
            SC[SC_A * SC_STRIDE + idx] = a[e]; SC[SC_M * SC_STRIDE + idx] = M; SC[SC_WU * SC_STRIDE + idx] = expf(a[e] - A);
            SC[SC_WI * SC_STRIDE + idx] = expf(m - M); SC[SC_FL * SC_STRIDE + idx] = expf(-(lb[e] + M)); }
        const float Mx = fmaxf(m, A), alpha = expf(m - Mx), beta = expf(A - Mx), mnext = F + Mx;
        if (lane == 0) { if (ctx) { CH[CH_BETAC + chain] = beta; oM[chain] = mnext; } else { CH[CH_ALPHA + (b * 8 + dirh) * 16 + c] = alpha; CH[CH_BETA + (b * 8 + dirh) * 16 + c] = beta; } }
        m = mnext;
    }
    }
}
__device__ __forceinline__ void ph_un(const bf16_t* __restrict__ KT, const float* __restrict__ CH, float* __restrict__ oN, float* __restrict__ UN, int bx, int G, int wv) {
    const int tid_ = otid(wv);
    for (int id = bx * 2 + (tid_ >> 8); id < 368; id += G * 2) { const int d = tid_ & 255;

    int dirh, tok0, slot = 0; const bool ctx = id < 128;
    if (ctx) { dirh = id & 7; tok0 = (id >> 3) * 256; }
    else { const int l = id - 128, b = l / 120, rem = l % 120, ci = rem % 15; dirh = rem / 15; const int c = (dirh >> 2) ? ci + 1 : ci; tok0 = NCTX + b * TLAT + c * 256; slot = (b * 8 + dirh) * 16 + c; }
    const bf16_t* p = KT + (size_t)((dirh >> 2) * 1024 + (dirh & 3) * 256 + d) * MTOK + tok0;
    float s = 0.f;
    for (int t = 0; t < 256; t += 8) { const pg8::u32x4 w = *(const pg8::u32x4*)(p + t);
        s += __uint_as_float(w.x << 16) + __uint_as_float(w.x & 0xffff0000u) + __uint_as_float(w.y << 16) + __uint_as_float(w.y & 0xffff0000u)
           + __uint_as_float(w.z << 16) + __uint_as_float(w.z & 0xffff0000u) + __uint_as_float(w.w << 16) + __uint_as_float(w.w & 0xffff0000u); }
    if (ctx) oN[(size_t)id * 256 + d] = CH[CH_BETAC + id] * s; else UN[(size_t)slot * 256 + d] = s;
    }
}
__device__ __forceinline__ void ph_cscan(const float* __restrict__ sC, const float* __restrict__ sN, const bf16_t* __restrict__ UT, const float* __restrict__ UN, const float* __restrict__ CH,
                                         bf16_t* __restrict__ CT, float* __restrict__ NT, int bx, int G, int wv) {
    for (int t = bx * 512 + otid(wv); t < 131072; t += G * 512) {

    const int dg = t & 31, e = (t >> 5) & 255, chain = t >> 13;
    const int dirh = chain & 7, dir = dirh >> 2;
    float C[8];
#pragma unroll
    for (int j = 0; j < 8; ++j) C[j] = sC[(size_t)chain * 65536 + (size_t)(dg * 8 + j) * 256 + e];
    for (int i = 0; i < 16; ++i) {
        const int c = dir ? 15 - i : i; const size_t so = ((size_t)(chain * 16 + c) * 256 + e) * 256 + dg * 8;
        pg8::u32x4 w; w.x = pg8::cvt_pk_bf16(C[0], C[1]); w.y = pg8::cvt_pk_bf16(C[2], C[3]); w.z = pg8::cvt_pk_bf16(C[4], C[5]); w.w = pg8::cvt_pk_bf16(C[6], C[7]);
        *(pg8::u32x4*)(CT + so) = w;
        if (i == 15) break;
        const float al = CH[CH_ALPHA + chain * 16 + c], be = CH[CH_BETA + chain * 16 + c];
        const pg8::u32x4 u = *(const pg8::u32x4*)(UT + so);
        const float uf[8] = {__uint_as_float(u.x << 16), __uint_as_float(u.x & 0xffff0000u), __uint_as_float(u.y << 16), __uint_as_float(u.y & 0xffff0000u),
                             __uint_as_float(u.z << 16), __uint_as_float(u.z & 0xffff0000u), __uint_as_float(u.w << 16), __uint_as_float(u.w & 0xffff0000u)};
#pragma unroll
        for (int j = 0; j < 8; ++j) C[j] = al * C[j] + be * uf[j];
    }
    if (t < 16 * 256) {
        const int ch2 = t >> 8, d = t & 255, dir2 = (ch2 & 7) >> 2; float n = sN[(size_t)ch2 * 256 + d];
        for (int i = 0; i < 16; ++i) { const int c = dir2 ? 15 - i : i; NT[(size_t)(ch2 * 16 + c) * 256 + d] = n; if (i == 15) break;
            n = CH[CH_ALPHA + ch2 * 16 + c] * n + CH[CH_BETA + ch2 * 16 + c] * UN[(size_t)(ch2 * 16 + c) * 256 + d]; }
    }
    }
}
__device__ __forceinline__ void ph_qkpost(bf16_t* __restrict__ QA, bf16_t* __restrict__ KA, const float* __restrict__ q_g, const float* __restrict__ k_g, float* __restrict__ ck_out, int bx, int G, int wv) {
    const int tid_ = otid(wv), lane = tid_ & 63;
    for (int gw = bx * 8 + (tid_ >> 6); gw < MTOK * 10; gw += G * 8) {
    const int row = gw / 10, hh = gw % 10, is_k = hh >= 8, head = is_k ? hh - 8 : hh, nheads = is_k ? 2 : 8; bf16_t* X = is_k ? KA : QA; const float* gain = is_k ? k_g : q_g;

    const int b = row < NCTX ? 0 : (row - NCTX) >> 12, tt = (row - NCTX) & 4095;
    const size_t xrow = (is_k && row >= NCTX) ? (size_t)(NCTX + b * KV_ROWS_LAT + tt) : (size_t)row;
    bf16_t* t = X + xrow * (nheads * 128) + head * 128;
    const int axis = lane >> 5, f = lane & 31, d0 = axis * 64 + f, d1 = d0 + 32;
    float x0 = bf2f(t[d0]), x1 = bf2f(t[d1]);
    const float ss = wave_sum(x0 * x0 + x1 * x1, lane);
    const float r = 1.f / sqrtf(ss * (1.f / 128.f) + EPS);
    x0 = x0 * r * gain[d0]; x1 = x1 * r * gain[d1];
    if (row < NCTX) {
        if (is_k) { ck_out[(size_t)row * 256 + head * 128 + d0] = x0; ck_out[(size_t)row * 256 + head * 128 + d1] = x1; }
    } else {
        const float pos = (float)(axis == 0 ? (tt >> 6) : (tt & 63));
        const float inv = powf(10000.f, -(float)f / 32.f);
        const float ang = pos * inv, cs = cosf(ang), sn = sinf(ang);
        const float y0 = x0 * cs - x1 * sn, y1 = x1 * cs + x0 * sn; x0 = y0; x1 = y1;
    }
    t[d0] = f2bf(x0); t[d1] = f2bf(x1);
    }
}
__device__ __forceinline__ void ph_ln(float* __restrict__ V, const float* __restrict__ g, const float* __restrict__ bta, const float* __restrict__ mod, bf16_t* __restrict__ H2, int bx, int G, int wv) {
    const int tid_ = otid(wv), lane = tid_ & 63;
    for (int row = bx * 8 + (tid_ >> 6); row < MTOK; row += G * 8) {

    float* v = V + (size_t)row * DM; float x[16], s = 0.f;
#pragma unroll
    for (int j = 0; j < 4; ++j)
#pragma unroll
        for (int e = 0; e < 4; ++e) { x[j * 4 + e] = v[j * 256 + lane * 4 + e]; s += x[j * 4 + e]; }
    const float mean = wave_sum(s, lane) * (1.f / DM); float q = 0.f;
#pragma unroll
    for (int i = 0; i < 16; ++i) { x[i] -= mean; q += x[i] * x[i]; }
    const float rstd = 1.f / sqrtf(wave_sum(q, lane) * (1.f / DM) + EPS);
    const float* md = mod + mod_index(row) * 6144;
#pragma unroll
    for (int j = 0; j < 4; ++j)
#pragma unroll
        for (int e = 0; e < 4; ++e) { const int c = j * 256 + lane * 4 + e; const float y = x[j * 4 + e] * rstd * g[c] + bta[c]; v[c] = y;
            if (H2) H2[(size_t)row * DM + c] = f2bf(y * (1.f + md[4096 + c]) + md[3072 + c]); }
    }
}

#define LAS __attribute__((address_space(3)))
#define XB_TMO      128
#define XB_XCNT(j)  (256  + 64 * (j))
#define XB_XSUB(j)  (1280 + 64 * (j))
#define XB_XGEN(j)  (2304 + 64 * (j))
#define XB_TOP      3328
#define XB_TOPGEN   3392
#define XCD_BAR_WORDS 3456
#define XB_SPIN_CAP (1u << 18)

__device__ __forceinline__ unsigned xb_ld(unsigned* p)              { return __hip_atomic_load(p, __ATOMIC_RELAXED, __HIP_MEMORY_SCOPE_AGENT); }
__device__ __forceinline__ unsigned xb_add(unsigned* p, unsigned v) { return __hip_atomic_fetch_add(p, v, __ATOMIC_RELAXED, __HIP_MEMORY_SCOPE_AGENT); }
__device__ __forceinline__ unsigned xb_xcc_id() { return (unsigned)__builtin_amdgcn_s_getreg((3 << 11) | 20) & 0xFu; }
#define XB_SPIN(cond, bar) do { unsigned _sp = 0; while (cond) { __builtin_amdgcn_s_sleep(1); \
    if ((++_sp & 255u) == 0u) { if (xb_ld(&(bar)[XB_TMO])) break; if (_sp > XB_SPIN_CAP) { atomicAdd(&(bar)[XB_TMO], 1u); break; } } } } while (0)

struct XcdBarrier {
    unsigned* bar; unsigned x;
    volatile LAS unsigned* st;
};

__device__ __forceinline__ XcdBarrier xcd_barrier_post(unsigned* bar, volatile LAS unsigned* st, bool leader) {
    XcdBarrier b; b.bar = bar; b.x = xb_xcc_id(); b.st = st;
    if (leader) (void)xb_add(&bar[XB_XCNT(b.x)], 1u);
    return b;
}
__device__ __forceinline__ void xcd_barrier_complete(unsigned* bar, unsigned x, unsigned& nloc, unsigned& nx) {
    const unsigned G = gridDim.x * gridDim.y * gridDim.z;
    unsigned sum, cnt, mine, sp = 0u;
    for (;;) {
        sum = 0u; cnt = 0u; mine = 0u;
#pragma unroll
        for (unsigned j = 0; j < 16; ++j) { const unsigned c = xb_ld(&bar[XB_XCNT(j)]); sum += c; cnt += (c > 0u) ? 1u : 0u; mine = (j == x) ? c : mine; }
        if (sum == G) break;
        __builtin_amdgcn_s_sleep(1);
        if ((++sp & 255u) == 0u) { if (xb_ld(&bar[XB_TMO])) break; if (sp > XB_SPIN_CAP) { atomicAdd(&bar[XB_TMO], 1u); break; } }
    }
    nloc = mine > 0u ? mine : 1u; nx = cnt > 0u ? cnt : 1u;
}

__device__ __forceinline__ void xcd_barrier(const XcdBarrier& b, int wv) {
    const bool leader_ = (wv == 0) && (__builtin_amdgcn_mbcnt_hi(~0u, __builtin_amdgcn_mbcnt_lo(~0u, 0u)) == 0u);
    asm volatile("s_waitcnt vmcnt(0)" ::: "memory");
    __syncthreads();
    if (leader_) {
        unsigned* bar = b.bar;
        __builtin_amdgcn_s_waitcnt(0);
        unsigned nloc = b.st[0], nx = b.st[1];
        if (nloc == 0u) { xcd_barrier_complete(bar, b.x, nloc, nx); b.st[0] = nloc; b.st[1] = nx; }
        const unsigned old = xb_add(&bar[XB_XSUB(b.x)], 1u);
        const unsigned gen = old / nloc;
        if (old + 1u == (gen + 1u) * nloc) {
            __builtin_amdgcn_fence(__ATOMIC_RELEASE, "agent");
            asm volatile("s_waitcnt vmcnt(0)" ::: "memory");
            const unsigned og = xb_add(&bar[XB_TOP], 1u);
            const unsigned tg = og / nx;
            if (og + 1u == (tg + 1u) * nx) xb_add(&bar[XB_TOPGEN], 1u);
            else XB_SPIN(xb_ld(&bar[XB_TOPGEN]) == tg, bar);
            __builtin_amdgcn_fence(__ATOMIC_ACQUIRE, "agent");
            xb_add(&bar[XB_XGEN(b.x)], 1u);
            asm volatile("s_waitcnt vmcnt(0)" ::: "memory");
        } else {
            XB_SPIN(xb_ld(&bar[XB_XGEN(b.x)]) == gen, bar);
            __builtin_amdgcn_fence(__ATOMIC_ACQUIRE, "agent");
            asm volatile("s_waitcnt vmcnt(0)" ::: "memory");
        }
    }
    __syncthreads();
}


constexpr int FG_LDS = 147456, MISC_OFF = 147200;
constexpr size_t WS_CTL = 768 * 1024, CTL_BYTES = 64 * 1024;
typedef const P __attribute__((address_space(4)))* KP;
__device__ __forceinline__ KP kargs() { KP k = (KP)__builtin_amdgcn_kernarg_segment_ptr(); asm volatile("" : "+s"(k)); return k; }
__global__ void __launch_bounds__(512, 2) k_mega(P p_unused) {
    extern __shared__ __attribute__((aligned(16))) unsigned char lds[];
    const int G = gridDim.x, bx = blockIdx.x, vcu = (G % 8 == 0) ? (bx % 8) * (G / 8) + bx / 8 : bx;
    volatile LAS unsigned* MISC = (volatile LAS unsigned*)((LAS unsigned char*)lds + MISC_OFF);
    const int wv = __builtin_amdgcn_readfirstlane(threadIdx.x >> 6);
    if (threadIdx.x < 64) MISC[threadIdx.x] = 0u;
    const bool leader0 = threadIdx.x == 0;
    __syncthreads();
    XcdBarrier bar = xcd_barrier_post((unsigned*)(kargs()->ws + WS_CTL), MISC + 8, leader0);
    PG8_LAS unsigned char* glds = (PG8_LAS unsigned char*)lds;
#define WSP(T, off) ((T*)(ws + (off)))
#define GEMM_PHASE(EPI, A_, lda_, Bt_, ldb_, M_, N_, K_, ...) do { pg8::Gemm g_{A_, Bt_, M_, N_, K_, lda_, ldb_, 0}; pg8::StaticOrder S_; S_.init(M_, N_, G, bx, lda_, ldb_); \
        pg8::gemm_phase<EPI, pg8::StaticOrder, true, true>(glds, g_, S_, EPI{__VA_ARGS__}, wv); } while (0)
    { KP k = kargs(); unsigned char* ws = k->ws;
      ph_mod(k->c, k->c_ctx, k->w_mod, k->b_mod, WSP(float, WS_MOD), lds, bx, G, wv);
      ph_cache(k->cache_k, k->cache_v, WSP(bf16_t, WS_KA), WSP(bf16_t, WS_VA), bx, G, wv);
      ph_weights(k->w_in, k->w_bm, k->w_ba, k->w_out, k->w_up, k->w_down, ws, lds, bx, G, wv); }
    xcd_barrier(bar, wv);
    { KP k = kargs(); unsigned char* ws = k->ws; ph_hgates(k->x_prompt, k->x_sample, k->w_in, k->b_gates, WSP(float, WS_MOD), WSP(bf16_t, WS_HB), WSP(float, WS_GATES), lds, bx, G, wv); }
    xcd_barrier(bar, wv);
    { KP k = kargs(); unsigned char* ws = k->ws; ph_scan(WSP(float, WS_GATES), k->state_m, WSP(float, WS_SC), WSP(float, WS_CH), k->out + O_SM, bx, G, wv); }
    xcd_barrier(bar, wv);
    { KP k = kargs(); unsigned char* ws = k->ws;
      GEMM_PHASE(pg8::EpiProj, WSP(bf16_t, WS_HB), DM, WSP(bf16_t, WS_WIN), DM, MTOK, 4608, DM, WSP(bf16_t, WS_QM), WSP(bf16_t, WS_OM), WSP(bf16_t, WS_QA), WSP(bf16_t, WS_KA), WSP(bf16_t, WS_VA), WSP(bf16_t, WS_KM),
                 WSP(bf16_t, WS_KM), WSP(bf16_t, WS_OM), k->out + O_CV, 0, 0); }
    { KP k = kargs(); unsigned char* ws = k->ws;
      GEMM_PHASE(pg8::EpiKVT, WSP(bf16_t, WS_WIN) + (size_t)R_KM * DM, DM, WSP(bf16_t, WS_HB), DM, 2048, MTOK, DM, WSP(bf16_t, WS_KFT), WSP(bf16_t, WS_VT), WSP(float, WS_SC) + SC_WU * SC_STRIDE); }
    xcd_barrier(bar, wv);
    { KP k = kargs(); unsigned char* ws = k->ws; ph_qkpost(WSP(bf16_t, WS_QA), WSP(bf16_t, WS_KA), k->q_g, k->k_g, k->out + O_CK, bx, G, wv); }
    { KP k = kargs(); unsigned char* ws = k->ws; ph_un(WSP(bf16_t, WS_KFT), WSP(float, WS_CH), k->out + O_SN, WSP(float, WS_UN), bx, G, wv); }
    { KP k = kargs(); unsigned char* ws = k->ws; pg8::Gemm g0{WSP(bf16_t, WS_KFT), WSP(bf16_t, WS_VT), 256, 256, 256, MTOK, MTOK, 0}; pg8::UOrder S0; S0.init(G, bx, 0);
      pg8::gemm_phase<pg8::EpiUctx, pg8::UOrder, false, true>(glds, g0, S0, pg8::EpiUctx{k->out + O_SC, WSP(float, WS_CH) + CH_BETAC}, wv); }
    { KP k = kargs(); unsigned char* ws = k->ws; pg8::Gemm g1{WSP(bf16_t, WS_VT), WSP(bf16_t, WS_KFT), 256, 256, 256, MTOK, MTOK, 0}; pg8::UOrder S1; S1.init(G, G - 1 - bx, 1);
      pg8::gemm_phase<pg8::EpiUlat, pg8::UOrder, false, true>(glds, g1, S1, pg8::EpiUlat{(bf16_t*)(k->out + O_Y)}, wv); }
    xcd_barrier(bar, wv);
    { KP k = kargs(); unsigned char* ws = k->ws; ph_cscan(k->state_C, k->state_n, (const bf16_t*)(k->out + O_Y), WSP(float, WS_UN), WSP(float, WS_CH), WSP(bf16_t, WS_KFT), WSP(float, WS_NT), bx, G, wv); }
    xcd_barrier(bar, wv);
    { KP k = kargs(); unsigned char* ws = k->ws; attn_phase(WSP(bf16_t, WS_QA), WSP(bf16_t, WS_KA), WSP(bf16_t, WS_VA), (char*)lds, vcu, G, wv); }
    { KP k = kargs(); unsigned char* ws = k->ws;
      for (int u = vcu; u < 384; u += G) { hu::hunit(u, WSP(bf16_t, WS_QM), WSP(bf16_t, WS_KM), WSP(bf16_t, WS_VT), WSP(bf16_t, WS_OM), WSP(bf16_t, WS_KFT), WSP(float, WS_NT), WSP(float, WS_SC), k->mlstm_g, lds, wv); __syncthreads(); } }
    xcd_barrier(bar, wv);
    { KP k = kargs(); unsigned char* ws = k->ws; GEMM_PHASE(pg8::EpiSig2, WSP(bf16_t, WS_HB), DM, WSP(bf16_t, WS_WIN) + (size_t)R_GM * DM, DM, MTOK, 2048, DM, WSP(bf16_t, WS_KM), WSP(bf16_t, WS_OM)); }
    { KP k = kargs(); unsigned char* ws = k->ws; GEMM_PHASE(pg8::EpiStoreF32, WSP(bf16_t, WS_QM), DM, WSP(bf16_t, WS_WBM), DM, MTOK, DM, DM, WSP(float, WS_KFT), DM, 0); }
    xcd_barrier(bar, wv);
    { KP k = kargs(); unsigned char* ws = k->ws; GEMM_PHASE(pg8::EpiMergeF, WSP(bf16_t, WS_QA), DM, WSP(bf16_t, WS_WBA), DM, MTOK, DM, DM, WSP(float, WS_KFT), WSP(bf16_t, WS_KM), WSP(bf16_t, WS_OM), WSP(bf16_t, WS_VT)); }
    xcd_barrier(bar, wv);
    { KP k = kargs(); unsigned char* ws = k->ws; GEMM_PHASE(pg8::EpiResidXF, WSP(bf16_t, WS_VT), DM, WSP(bf16_t, WS_WOUT), DM, MTOK, DM, DM, k->x_prompt, k->x_sample, WSP(float, WS_MOD), k->out + O_Y, 2048, 0); }
    xcd_barrier(bar, wv);
    { KP k = kargs(); unsigned char* ws = k->ws; ph_ln(k->out + O_Y, k->ln1_g, k->ln1_b, WSP(float, WS_MOD), WSP(bf16_t, WS_HB), bx, G, wv); }
    xcd_barrier(bar, wv);
    { KP k = kargs(); unsigned char* ws = k->ws; GEMM_PHASE(pg8::EpiRelu2F, WSP(bf16_t, WS_HB), DM, WSP(bf16_t, WS_WUP), DM, MTOK, DFF, DM, WSP(bf16_t, WS_KM), DFF, 0); }
    xcd_barrier(bar, wv);
    { KP k = kargs(); unsigned char* ws = k->ws; GEMM_PHASE(pg8::EpiResidInF, WSP(bf16_t, WS_KM), DFF, WSP(bf16_t, WS_WDN), DFF, MTOK, DM, DFF, WSP(float, WS_MOD), k->out + O_Y, 5120, 0); }
    xcd_barrier(bar, wv);
    { KP k = kargs(); unsigned char* ws = k->ws; ph_ln(k->out + O_Y, k->ln2_g, k->ln2_b, WSP(float, WS_MOD), (bf16_t*)nullptr, bx, G, wv); }
}

extern "C" void kernel_launch(void* const* d_in, const int* in_sizes, int n_in, void* d_out, int out_size, void* d_ws, size_t ws_size, hipStream_t stream) {
    static int grid = 0;
    if (grid == 0) {
        int dev = 0, cus = 0, per_cu = 0;
        (void)hipGetDevice(&dev); (void)hipDeviceGetAttribute(&cus, hipDeviceAttributeMultiprocessorCount, dev);
        if (hipFuncSetAttribute((const void*)k_mega, hipFuncAttributeMaxDynamicSharedMemorySize, FG_LDS) != hipSuccess) fprintf(stderr, "kernel_launch: hipFuncSetAttribute failed\n");
        if (hipOccupancyMaxActiveBlocksPerMultiprocessor(&per_cu, (const void*)k_mega, 512, FG_LDS) != hipSuccess || per_cu < 1) { fprintf(stderr, "kernel_launch: occupancy query says %d blocks per CU\n", per_cu); per_cu = 1; }
        (void)hipGetLastError();
        grid = cus > 0 ? cus : 256;
    }
    (void)hipMemsetAsync((unsigned char*)d_ws + WS_CTL, 0, CTL_BYTES, stream);
    P p{};
    const float** pf = (const float**)&p;
    for (int i = 0; i < 25; ++i) pf[i] = (const float*)d_in[i];
    p.out = (float*)d_out; p.ws = (unsigned char*)d_ws;
    void* args[] = {&p};
    hipError_t e = hipLaunchCooperativeKernel((const void*)k_mega, dim3(grid), dim3(512), args, FG_LDS, stream);
    if (e != hipSuccess) fprintf(stderr, "kernel_launch: cooperative launch failed: %s (grid %d)\n", hipGetErrorString(e), grid);
}
```

```cpp
#include <hip/hip_runtime.h>
#include <cstdint>
#include <cstdio>

typedef unsigned short bf16_t;
typedef float f32x4 __attribute__((ext_vector_type(4)));

constexpr int DM = 1024, NCTX = 4096, NLAT = 8192, MTOK = NCTX + NLAT, DIN = 7696, DFF = 4096;
constexpr int TCTX = 256, TLAT = 4096, PAST = 256, NSEQ_CTX = 16, NSEQ_LAT = 2;
constexpr int KV_ROWS_LAT = TLAT + PAST;
constexpr int KV_ROWS = NCTX + NSEQ_LAT * KV_ROWS_LAT;
constexpr float EPS = 1e-6f;
constexpr float ALPHA = 1.189207115002721f;
constexpr int C_QM = 0, C_KM = 1024, C_VM = 2048, C_OM = 3072, C_GATES = 4096, C_QA = 4112, C_KA = 5136, C_VA = 5392, C_GM = 5648, C_GA = 6672;
constexpr size_t O_Y = 0, O_CK = (size_t)MTOK * DM, O_CV = O_CK + 1048576, O_SC = O_CV + 1048576, O_SN = O_SC + 8388608, O_SM = O_SN + 32768;
constexpr size_t MiB = 1u << 20;
constexpr size_t WS_MOD = 0, WS_CH = 128 * 1024, WS_UN = 256 * 1024, WS_NT = 512 * 1024, WS_GATES = 1 * MiB, WS_SC = 2 * MiB, WS_HB = 4 * MiB, WS_QM = 28 * MiB, WS_QA = 52 * MiB,
                 WS_KA = 76 * MiB, WS_VA = 83 * MiB, WS_KM = 90 * MiB, WS_OM = 114 * MiB, WS_VT = 138 * MiB, WS_KFT = 162 * MiB, WS_KBT = 186 * MiB,
                 WS_WIN = 210 * MiB, WS_WBM = 225 * MiB, WS_WBA = 227 * MiB, WS_WOUT = 229 * MiB, WS_WUP = 231 * MiB, WS_WDN = 239 * MiB;
constexpr int R_QM = 0, R_OM = 1024, R_QA = 2048, R_KA = 3072, R_VA = 3328, R_KM = 3584, R_VM = 4608, R_GM = 5632, R_GA = 6656;
constexpr int SC_A = 0, SC_P = 1, SC_WU = 2, SC_LB = 3; constexpr size_t SC_STRIDE = (size_t)8 * MTOK;
constexpr int CH_F = 0, CH_A = 256, CH_BETAC = 512, CH_MC = 640;

__device__ __forceinline__ bf16_t f2bf(float f) { unsigned u = __float_as_uint(f); u += 0x7fffu + ((u >> 16) & 1u); return (bf16_t)(u >> 16); }
__device__ __forceinline__ float bf2f(bf16_t b) { return __uint_as_float(((unsigned)b) << 16); }
__device__ __forceinline__ float sigmoidf_(float x) { return 1.f / (1.f + expf(-x)); }
__device__ __forceinline__ float shx(float v, int o, int lane) { return __int_as_float(__builtin_amdgcn_ds_bpermute((lane ^ o) << 2, __float_as_int(v))); }
__device__ __forceinline__ float shup(float v, int d, int lane) { return __int_as_float(__builtin_amdgcn_ds_bpermute((lane - d) << 2, __float_as_int(v))); }
__device__ __forceinline__ float rdlane63(float v) { return __int_as_float(__builtin_amdgcn_readlane(__float_as_int(v), 63)); }
__device__ __forceinline__ float wave_sum(float v, int lane) {
#pragma unroll
    for (int o = 1; o < 64; o <<= 1) v += shx(v, o, lane);
    return v;
}
__device__ __forceinline__ int otid(int wv) { int l; asm volatile("v_mbcnt_lo_u32_b32 %0, -1, 0\n\tv_mbcnt_hi_u32_b32 %0, -1, %0" : "=v"(l)); return wv * 64 + l; }
__device__ __forceinline__ int mod_index(int row) { return row < NCTX ? 0 : 1 + ((row - NCTX) >> 12); }
__device__ __forceinline__ const float* xrow_ptr(const float* xp, const float* xs, int row) { return row < NCTX ? xp + (size_t)row * DM : xs + (size_t)(row - NCTX) * DM; }

namespace pg8 {
#define PG8_LAS __attribute__((address_space(3)))
typedef unsigned short bf16_t;
typedef short bf16x8 __attribute__((ext_vector_type(8)));
typedef float f32x4 __attribute__((ext_vector_type(4)));
typedef unsigned u32x4 __attribute__((ext_vector_type(4)));
constexpr int BM = 256, BK = 64, HALF = 128, HTB = HALF * BK * 2  , STAGE_BYTES = 8 * HTB, NXCD = 8, WGM = 8;

__host__ __device__ __forceinline__ int lds_byte(int r, int c) { const int st = (r >> 4) * 2 + (c >> 5), rr = r & 15, cc = c & 31, ob = rr * 64 + cc * 2; return st * 1024 + (ob ^ (((ob >> 9) & 1) << 5)); }
__host__ __device__ __forceinline__ void stage_rc(int b, int& R, int& C) { const int st = b / 1024, sb = b % 1024, swz = sb ^ (((sb >> 9) & 1) << 5); R = (st >> 1) * 16 + swz / 64; C = (st & 1) * 32 + (swz % 64) / 2; }
__host__ __device__ __forceinline__ int perm32(int rho) { const int n = rho >> 4, i = rho & 15; return 8 * (i >> 2) + 4 * n + (i & 3); }

struct Unit { int pm, pn; };
__device__ __forceinline__ const char* uptr(const char* p) {
    const unsigned long long v = (unsigned long long)p; const unsigned lo = __builtin_amdgcn_readfirstlane((unsigned)v), hi = __builtin_amdgcn_readfirstlane((unsigned)(v >> 32));
    return (const char*)(((unsigned long long)hi << 32) | lo); }
struct Gemm { const bf16_t* A; const bf16_t* Bt; int M, N, K, lda, ldb, pad; };

struct StaticOrder {
    int nM, nN, nwg, G, c; size_t ta, tb;
    __host__ __device__ void init(int M, int N, int G_, int c_, int lda, int ldb) { nM = M / BM; nN = N / BM; nwg = nM * nN; G = G_; c = c_; ta = (size_t)BM * lda * 2; tb = (size_t)BM * ldb * 2; }
    __device__ __forceinline__ size_t a_off(const Unit& u) const { return (size_t)u.pm * ta; }
    __device__ __forceinline__ size_t b_off(const Unit& u) const { return (size_t)u.pn * tb; }
    __host__ __device__ bool next(int i, Unit& u) const { const long L = (long)i * G + c; if (L >= nwg) return false; map((int)L, u); return true; }
    __host__ __device__ bool map(int L, Unit& u) const {
        int wgid = L; { const int q = nwg / NXCD, r = nwg % NXCD, xcd = wgid % NXCD, off = wgid / NXCD; wgid = (xcd < r ? xcd * (q + 1) : r * (q + 1) + (xcd - r) * q) + off; }
        const int nig = WGM * nN, gid = wgid / nig, fm = gid * WGM, gsz = (nM - fm) < WGM ? (nM - fm) : WGM;
        u.pm = fm + ((wgid % nig) % gsz); u.pn = (wgid % nig) / gsz; return true;
    }
    __device__ __forceinline__ void a_ready(const Unit&) const {}
    __device__ __forceinline__ void done(const Unit&) const {}
};


typedef unsigned u32x2 __attribute__((ext_vector_type(2)));
__device__ __forceinline__ float fsig(float x) { return __builtin_amdgcn_rcpf(1.f + __builtin_amdgcn_exp2f(-1.4426950408889634f * x)); }
typedef float f32x2_t __attribute__((ext_vector_type(2))); typedef __bf16 bf16x2_t __attribute__((ext_vector_type(2)));
__device__ __forceinline__ unsigned cvt_pk_bf16(float lo, float hi) { f32x2_t v = {lo, hi}; bf16x2_t b = __builtin_convertvector(v, bf16x2_t); return __builtin_bit_cast(unsigned, b); }
__device__ __forceinline__ f32x4 bf4_to_f32(u32x2 w) { return (f32x4){__uint_as_float(w.x << 16), __uint_as_float(w.x & 0xffff0000u), __uint_as_float(w.y << 16), __uint_as_float(w.y & 0xffff0000u)}; }
struct EpiProj {
    static constexpr bool PERM = true, AFTER_DRAIN = false;
    bf16_t *QM, *OM, *QA, *KA, *VA, *KM, *GM, *GA; float* cv_out; int pn0, pad;
    __device__ __forceinline__ void operator()(const f32x4 (&acc)[2][2][4][2], const Unit& u, int wr, int wc, int fr, int fq) const {
        const int pn = u.pn + pn0; bf16_t* base; int ld = 1024, colt, act = 0; float sc = 1.f; bool kv = false;
        if (pn < 4) { base = QM; colt = pn * 256; }
        else if (pn < 8) { base = OM; colt = (pn - 4) * 256; act = 1; }
        else if (pn < 12) { base = QA; colt = (pn - 8) * 256; }
        else if (pn == 12) { base = KA; colt = 0; ld = 256; kv = true; }
        else if (pn == 13) { base = VA; colt = 0; ld = 256; kv = true; }
        else if (pn < 18) { base = KM; colt = (pn - 14) * 256; sc = 0.0625f; }
        else if (pn < 22) { base = GM; colt = (pn - 18) * 256; act = 1; }
        else { base = GA; colt = (pn - 22) * 256; act = 1; }
        const int row0 = u.pm * BM + wr * 64 + fr, radd = (kv && u.pm >= 16) ? ((u.pm - 16) >> 4) * 256 : 0, col0 = colt + wc * 32 + 8 * fq;
        const bool cvo = (pn == 13 && u.pm < 16);
#pragma unroll
        for (int ai = 0; ai < 2; ++ai)
#pragma unroll
            for (int m = 0; m < 4; ++m) { const int r = row0 + ai * HALF + m * 16; bf16_t* rowp = base + (size_t)(r + radd) * ld + col0;
#pragma unroll
                for (int bj = 0; bj < 2; ++bj) { f32x4 v0 = acc[ai][bj][m][0] * sc, v1 = acc[ai][bj][m][1] * sc;
                    if (act) {
#pragma unroll
                        for (int e = 0; e < 4; ++e) { v0[e] = fsig(v0[e]); v1[e] = fsig(v1[e]); } }
                    u32x4 w; w.x = cvt_pk_bf16(v0[0], v0[1]); w.y = cvt_pk_bf16(v0[2], v0[3]); w.z = cvt_pk_bf16(v1[0], v1[1]); w.w = cvt_pk_bf16(v1[2], v1[3]);
                    *(u32x4*)(rowp + bj * HALF) = w;
                    if (cvo) { float* cp = cv_out + (size_t)r * 256 + col0 + bj * HALF; *(f32x4*)cp = v0; *(f32x4*)(cp + 4) = v1; } } }
    }
};
struct EpiKVT {
    static constexpr bool PERM = true, AFTER_DRAIN = false;
    bf16_t* KT; bf16_t* VT; const float* wU;
    __device__ __forceinline__ void operator()(const f32x4 (&acc)[2][2][4][2], const Unit& u, int wr, int wc, int fr, int fq) const {
        const int head = u.pm & 3, tok0 = u.pn * BM + wc * 32 + 8 * fq; const bool isk = u.pm < 4;
        f32x4 wf[2][2], wb[2][2];
        if (isk) {
#pragma unroll
            for (int bj = 0; bj < 2; ++bj)
#pragma unroll
                for (int n = 0; n < 2; ++n) { wf[bj][n] = *(const f32x4*)(wU + (size_t)head * MTOK + tok0 + bj * HALF + 4 * n) * 0.0625f; wb[bj][n] = *(const f32x4*)(wU + (size_t)(4 + head) * MTOK + tok0 + bj * HALF + 4 * n) * 0.0625f; } }
#pragma unroll
        for (int ai = 0; ai < 2; ++ai)
#pragma unroll
            for (int m = 0; m < 4; ++m) { const int fl = head * 256 + ai * HALF + wr * 64 + m * 16 + fr;
#pragma unroll
                for (int bj = 0; bj < 2; ++bj) { const size_t o = (size_t)fl * MTOK + tok0 + bj * HALF; const f32x4 a0 = acc[ai][bj][m][0], a1 = acc[ai][bj][m][1];
                    if (isk) { f32x4 v0 = a0 * wf[bj][0], v1 = a1 * wf[bj][1]; u32x4 w; w.x = cvt_pk_bf16(v0[0], v0[1]); w.y = cvt_pk_bf16(v0[2], v0[3]); w.z = cvt_pk_bf16(v1[0], v1[1]); w.w = cvt_pk_bf16(v1[2], v1[3]); *(u32x4*)(KT + o) = w;
                        v0 = a0 * wb[bj][0]; v1 = a1 * wb[bj][1]; w.x = cvt_pk_bf16(v0[0], v0[1]); w.y = cvt_pk_bf16(v0[2], v0[3]); w.z = cvt_pk_bf16(v1[0], v1[1]); w.w = cvt_pk_bf16(v1[2], v1[3]); *(u32x4*)(KT + (size_t)1024 * MTOK + o) = w; }
                    else { u32x4 w; w.x = cvt_pk_bf16(a0[0], a0[1]); w.y = cvt_pk_bf16(a0[2], a0[3]); w.z = cvt_pk_bf16(a1[0], a1[1]); w.w = cvt_pk_bf16(a1[2], a1[3]); *(u32x4*)(VT + o) = w; } } }
    }
};
struct EpiSig2 {
    static constexpr bool PERM = true, AFTER_DRAIN = false; bf16_t* GM; bf16_t* GA;
    __device__ __forceinline__ void operator()(const f32x4 (&acc)[2][2][4][2], const Unit& u, int wr, int wc, int fr, int fq) const {
        bf16_t* base = u.pn < 4 ? GM : GA; const int row0 = u.pm * BM + wr * 64 + fr, col0 = (u.pn & 3) * 256 + wc * 32 + 8 * fq;
#pragma unroll
        for (int ai = 0; ai < 2; ++ai)
#pragma unroll
            for (int m = 0; m < 4; ++m) { bf16_t* rowp = base + (size_t)(row0 + ai * HALF + m * 16) * 1024 + col0;
#pragma unroll
                for (int bj = 0; bj < 2; ++bj) { f32x4 v0 = acc[ai][bj][m][0], v1 = acc[ai][bj][m][1];
#pragma unroll
                    for (int e = 0; e < 4; ++e) { v0[e] = fsig(v0[e]); v1[e] = fsig(v1[e]); }
                    u32x4 w; w.x = cvt_pk_bf16(v0[0], v0[1]); w.y = cvt_pk_bf16(v0[2], v0[3]); w.z = cvt_pk_bf16(v1[0], v1[1]); w.w = cvt_pk_bf16(v1[2], v1[3]);
                    *(u32x4*)(rowp + bj * HALF) = w; } }
    }
};
struct EpiUctx {
    static constexpr bool PERM = false, AFTER_DRAIN = false; float* oC; const float* betac;
    __device__ __forceinline__ void operator()(const f32x4 (&acc)[2][2][4][2], const Unit& u, int wr, int wc, int fr, int fq) const {
        const float beta = betac[u.pm]; float* ob = oC + (size_t)u.pm * 65536;
#pragma unroll
        for (int ai = 0; ai < 2; ++ai)
#pragma unroll
            for (int m = 0; m < 4; ++m) { float* rowp = ob + (size_t)(ai * HALF + wr * 64 + m * 16 + fr) * 256 + wc * 32 + 4 * fq;
#pragma unroll
                for (int bj = 0; bj < 2; ++bj)
#pragma unroll
                    for (int n = 0; n < 2; ++n) *(f32x4*)(rowp + bj * HALF + n * 16) = acc[ai][bj][m][n] * beta;
                asm volatile("" ::: "memory"); }
    }
};
struct EpiUlat {
    static constexpr bool PERM = true, AFTER_DRAIN = false; bf16_t* UT;
    __device__ __forceinline__ void operator()(const f32x4 (&acc)[2][2][4][2], const Unit& u, int wr, int wc, int fr, int fq) const {
        const int id = u.pm, b = id / 120, rem = id % 120, dirh = rem / 15, ci = rem % 15, c = (dirh >> 2) ? ci + 1 : ci;
        bf16_t* ob = UT + (size_t)((b * 8 + dirh) * 16 + c) * 65536;
#pragma unroll
        for (int ai = 0; ai < 2; ++ai)
#pragma unroll
            for (int m = 0; m < 4; ++m) { bf16_t* rowp = ob + (size_t)(ai * HALF + wr * 64 + m * 16 + fr) * 256 + wc * 32 + 8 * fq;
#pragma unroll
                for (int bj = 0; bj < 2; ++bj) { const f32x4 v0 = acc[ai][bj][m][0], v1 = acc[ai][bj][m][1];
                    u32x4 w; w.x = cvt_pk_bf16(v0[0], v0[1]); w.y = cvt_pk_bf16(v0[2], v0[3]); w.z = cvt_pk_bf16(v1[0], v1[1]); w.w = cvt_pk_bf16(v1[2], v1[3]);
                    *(u32x4*)(rowp + bj * HALF) = w; }
                asm volatile("" ::: "memory"); }
    }
};
struct UOrder {
    int G, c, mode, n;
    __device__ __forceinline__ void init(int G_, int c_, int mode_) { G = G_; c = c_; mode = mode_; n = mode_ ? 240 : 128; }
    __device__ __forceinline__ bool next(int i, Unit& u) const { const int L = i * G + c; if (L >= n) return false; u.pm = L; u.pn = L; return true; }
    __device__ __forceinline__ void offs(int id, size_t& ko, size_t& vo) const {
        int dirh, tok0;
        if (mode == 0) { dirh = id & 7; tok0 = (id >> 3) * 256; }
        else { const int b = id / 120, rem = id % 120, ci = rem % 15; dirh = rem / 15; tok0 = NCTX + b * TLAT + ((dirh >> 2) ? ci + 1 : ci) * 256; }
        const int dir = dirh >> 2, h = dirh & 3;
        ko = ((size_t)(dir * 1024 + h * 256) * MTOK + tok0) * 2; vo = ((size_t)(h * 256) * MTOK + tok0) * 2;
    }
    __device__ __forceinline__ size_t a_off(const Unit& u) const { size_t ko, vo; offs(u.pm, ko, vo); return mode == 0 ? ko : vo; }
    __device__ __forceinline__ size_t b_off(const Unit& u) const { size_t ko, vo; offs(u.pm, ko, vo); return mode == 0 ? vo : ko; }
    __device__ __forceinline__ void a_ready(const Unit&) const {}
    __device__ __forceinline__ void done(const Unit&) const {}
};

struct P1Order {
    StaticOrder SA, SB; int G, c;
    __device__ __forceinline__ void init(int G_, int c_) { G = G_; c = c_; SA.init(MTOK, 4608, G_, c_, DM, DM); SB.init(2048, MTOK, G_, c_, DM, DM); }
    __device__ __forceinline__ bool next(int i, Unit& u) const { const int L = i * G + c; if (L >= 1248) return false; if (L < 864) SA.map(L, u); else { SB.map(L - 864, u); u.pn += 100; } return true; }
    __device__ __forceinline__ size_t a_off(const Unit& u) const { return u.pn < 100 ? WS_HB + (size_t)u.pm * SA.ta : WS_WIN + (size_t)R_KM * DM * 2 + (size_t)u.pm * SB.ta; }
    __device__ __forceinline__ size_t b_off(const Unit& u) const { return u.pn < 100 ? WS_WIN + (size_t)u.pn * SA.tb : WS_HB + (size_t)(u.pn - 100) * SB.tb; }
    __device__ __forceinline__ void a_ready(const Unit&) const {}
    __device__ __forceinline__ void done(const Unit&) const {}
};
struct EpiP1 {
    static constexpr bool PERM = true, AFTER_DRAIN = false; EpiProj a; EpiKVT b;
    __device__ __forceinline__ void operator()(const f32x4 (&acc)[2][2][4][2], const Unit& u, int wr, int wc, int fr, int fq) const {
        if (u.pn < 100) a(acc, u, wr, wc, fr, fq); else { Unit u2; u2.pm = u.pm; u2.pn = u.pn - 100; b(acc, u2, wr, wc, fr, fq); }
    }
};
struct SigOrder {
    StaticOrder S; int c, G;
    __device__ __forceinline__ void init(int G_, int c_) { G = G_; c = c_; S.init(MTOK, 2048, G_, c_, DM, DM); }
    __device__ __forceinline__ bool next(int i, Unit& u) const {
        int L;
        if (G == 256) { if (c < 128) { if (i > 0) return false; L = c; } else { if (i > 1) return false; L = 128 + (c - 128) * 2 + i; } }
        else { L = i * G + c; if (L >= 384) return false; }
        S.map(L, u); return true; }
    __device__ __forceinline__ size_t a_off(const Unit& u) const { return S.a_off(u); }
    __device__ __forceinline__ size_t b_off(const Unit& u) const { return S.b_off(u); }
    __device__ __forceinline__ void a_ready(const Unit&) const {}
    __device__ __forceinline__ void done(const Unit&) const {}
};
struct EpiStoreF32 {
    static constexpr bool PERM = false, AFTER_DRAIN = false; float* O; int ld, pad;
    __device__ __forceinline__ void operator()(const f32x4 (&acc)[2][2][4][2], const Unit& u, int wr, int wc, int fr, int fq) const {
        const int row0 = u.pm * BM + wr * 64 + fr, col0 = u.pn * BM + wc * 32 + 4 * fq;
#pragma unroll
        for (int ai = 0; ai < 2; ++ai)
#pragma unroll
            for (int m = 0; m < 4; ++m) { float* rowp = O + (size_t)(row0 + ai * HALF + m * 16) * ld + col0;
#pragma unroll
                for (int bj = 0; bj < 2; ++bj)
#pragma unroll
                    for (int n = 0; n < 2; ++n) *(f32x4*)(rowp + bj * HALF + n * 16) = acc[ai][bj][m][n]; }
    }
};
struct EpiMergeF {
    static constexpr bool PERM = false, AFTER_DRAIN = false; const float* Y1; const bf16_t* GM; const bf16_t* GA; bf16_t* O;
    __device__ __forceinline__ void operator()(const f32x4 (&acc)[2][2][4][2], const Unit& u, int wr, int wc, int fr, int fq) const {
        const int row0 = u.pm * BM + wr * 64 + fr, col0 = u.pn * BM + wc * 32 + 4 * fq;
#pragma unroll
        for (int ai = 0; ai < 2; ++ai)
#pragma unroll
            for (int m = 0; m < 4; ++m) { const size_t ro = (size_t)(row0 + ai * HALF + m * 16) * 1024 + col0;
#pragma unroll
                for (int bj = 0; bj < 2; ++bj)
#pragma unroll
                    for (int n = 0; n < 2; ++n) { const size_t i = ro + bj * HALF + n * 16;
                        const f32x4 y1 = *(const f32x4*)(Y1 + i), gm = bf4_to_f32(*(const u32x2*)(GM + i)), ga = bf4_to_f32(*(const u32x2*)(GA + i));
                        const f32x4 o = gm * y1 + ga * acc[ai][bj][m][n]; u32x2 w; w.x = cvt_pk_bf16(o[0], o[1]); w.y = cvt_pk_bf16(o[2], o[3]); *(u32x2*)(O + i) = w; } }
    }
};
struct EpiResidXF {
    static constexpr bool PERM = false, AFTER_DRAIN = false; const float* xp; const float* xs; const float* mod; float* O; int goff, pad;
    __device__ __forceinline__ void operator()(const f32x4 (&acc)[2][2][4][2], const Unit& u, int wr, int wc, int fr, int fq) const {
        const int row0 = u.pm * BM + wr * 64 + fr, col0 = u.pn * BM + wc * 32 + 4 * fq;
        const float* xb = u.pm < 16 ? xp : xs - (size_t)4096 * 1024; const float* md = mod + (u.pm < 16 ? 0 : 1 + ((u.pm - 16) >> 4)) * 6144 + goff;
#pragma unroll
        for (int ai = 0; ai < 2; ++ai)
#pragma unroll
            for (int m = 0; m < 4; ++m) { const size_t ro = (size_t)(row0 + ai * HALF + m * 16) * 1024 + col0;
#pragma unroll
                for (int bj = 0; bj < 2; ++bj)
#pragma unroll
                    for (int n = 0; n < 2; ++n) { const int c = col0 + bj * HALF + n * 16; const size_t i = ro + bj * HALF + n * 16;
                        *(f32x4*)(O + i) = *(const f32x4*)(xb + i) * 1.189207115002721f + *(const f32x4*)(md + c) * acc[ai][bj][m][n]; } }
    }
};
struct EpiResidInF {
    static constexpr bool PERM = false, AFTER_DRAIN = false; const float* mod; float* O; int goff, pad;
    __device__ __forceinline__ void operator()(const f32x4 (&acc)[2][2][4][2], const Unit& u, int wr, int wc, int fr, int fq) const {
        const int row0 = u.pm * BM + wr * 64 + fr, col0 = u.pn * BM + wc * 32 + 4 * fq;
        const float* md = mod + (u.pm < 16 ? 0 : 1 + ((u.pm - 16) >> 4)) * 6144 + goff;
#pragma unroll
        for (int ai = 0; ai < 2; ++ai)
#pragma unroll
            for (int m = 0; m < 4; ++m) { const size_t ro = (size_t)(row0 + ai * HALF + m * 16) * 1024 + col0;
#pragma unroll
                for (int bj = 0; bj < 2; ++bj)
#pragma unroll
                    for (int n = 0; n < 2; ++n) { const int c = col0 + bj * HALF + n * 16; const size_t i = ro + bj * HALF + n * 16;
                        *(f32x4*)(O + i) = *(const f32x4*)(O + i) * 1.189207115002721f + *(const f32x4*)(md + c) * acc[ai][bj][m][n]; } }
    }
};
struct EpiRelu2F {
    static constexpr bool PERM = true, AFTER_DRAIN = false; bf16_t* O; int ld, pad;
    __device__ __forceinline__ void operator()(const f32x4 (&acc)[2][2][4][2], const Unit& u, int wr, int wc, int fr, int fq) const {
        const int row0 = u.pm * BM + wr * 64 + fr, col0 = u.pn * BM + wc * 32 + 8 * fq;
#pragma unroll
        for (int ai = 0; ai < 2; ++ai)
#pragma unroll
            for (int m = 0; m < 4; ++m) { bf16_t* rowp = O + (size_t)(row0 + ai * HALF + m * 16) * ld + col0;
#pragma unroll
                for (int bj = 0; bj < 2; ++bj) { f32x4 v0 = acc[ai][bj][m][0], v1 = acc[ai][bj][m][1];
#pragma unroll
                    for (int e = 0; e < 4; ++e) { const float a = fmaxf(v0[e], 0.f), b = fmaxf(v1[e], 0.f); v0[e] = a * a; v1[e] = b * b; }
                    u32x4 w; w.x = cvt_pk_bf16(v0[0], v0[1]); w.y = cvt_pk_bf16(v0[2], v0[3]); w.z = cvt_pk_bf16(v1[0], v1[1]); w.w = cvt_pk_bf16(v1[2], v1[3]);
                    *(u32x4*)(rowp + bj * HALF) = w; } }
    }
};
template <class Epi, class Sched, bool ALIGN_EPI = false, bool SP2 = false>
__device__ __forceinline__ void gemm_phase(PG8_LAS unsigned char* lds, const Gemm g, const Sched& S, const Epi& E, int wv) {
    const int tid = otid(wv), wid = __builtin_amdgcn_readfirstlane(tid >> 6), lane = tid & 63, wr = wid >> 2, wc = wid & 3, fr = lane & 15, fq = lane >> 4;
    const int K = g.K, nt = K / BK;
    unsigned voffA[2], voffB[2];
#pragma unroll
    for (int i = 0; i < 2; ++i) { int R, C; stage_rc(tid * 16 + i * 8192, R, C); const int Rb = Epi::PERM ? ((R & ~31) + perm32(R & 31)) : R;
        voffA[i] = (unsigned)(R * g.lda + C) * 2u; voffB[i] = (unsigned)(Rb * g.ldb + C) * 2u; }
    const size_t kstep = (size_t)(BK * 2);
    const size_t hstepA = (size_t)HALF * g.lda * 2, hstepB = (size_t)HALF * g.ldb * 2;
    const unsigned ldsw = (unsigned)wid * 1024u;
    const int aoff = lds_byte(wr * 64 + fr, fq * 8), boff = lds_byte(wc * 32 + fr, fq * 8);
#define PG8_SA(b, h) (((b) * 2 + (h)) * HTB)
#define PG8_SB(b, h) ((4 + (b) * 2 + (h)) * HTB)
#define PG8_STAGE(bufoff, gbase, voff) do { _Pragma("unroll") for (int _i = 0; _i < 2; ++_i) \
        __builtin_amdgcn_global_load_lds((const unsigned*)((const char*)(gbase) + (voff)[_i]), (PG8_LAS unsigned*)(lds + (bufoff) + ldsw + _i * 8192), 16, 0, 0); } while (0)
#define PG8_LDA(dst, b, h) do { _Pragma("unroll") for (int m = 0; m < 4; ++m) _Pragma("unroll") for (int k = 0; k < 2; ++k) dst[m][k] = *(const PG8_LAS bf16x8*)(lds + PG8_SA(b, h) + aoff + m * 2048 + k * 1024); } while (0)
#define PG8_LDB(dst, b, h) do { _Pragma("unroll") for (int n = 0; n < 2; ++n) _Pragma("unroll") for (int k = 0; k < 2; ++k) dst[n][k] = *(const PG8_LAS bf16x8*)(lds + PG8_SB(b, h) + boff + n * 2048 + k * 1024); } while (0)
#define PG8_MMA(ai, bj, At, Bt) do { __builtin_amdgcn_s_setprio(1); _Pragma("unroll") for (int m = 0; m < 4; ++m) _Pragma("unroll") for (int n = 0; n < 2; ++n) _Pragma("unroll") for (int k = 0; k < 2; ++k) \
        acc[ai][bj][m][n] = __builtin_amdgcn_mfma_f32_16x16x32_bf16(Bt[n][k], At[m][k], acc[ai][bj][m][n], 0, 0, 0); __builtin_amdgcn_s_setprio(0); } while (0)
#define PG8_WAIT_V(n) asm volatile("s_waitcnt vmcnt(" #n ")" ::: "memory")
#define PG8_WAIT_L(n) asm volatile("s_waitcnt lgkmcnt(" #n ")" ::: "memory")
#define PG8_BAR __builtin_amdgcn_s_barrier()
#define PG8_SCHED __builtin_amdgcn_sched_barrier(0)
    Unit cur, nxt; int ui = 0;
    if (!S.next(0, cur)) return;
    f32x4 acc[2][2][4][2];
#pragma unroll
    for (int a = 0; a < 2; ++a)
#pragma unroll
        for (int b = 0; b < 2; ++b)
#pragma unroll
            for (int m = 0; m < 4; ++m)
#pragma unroll
                for (int n = 0; n < 2; ++n) acc[a][b][m][n] = (f32x4){0.f, 0.f, 0.f, 0.f};
    bf16x8 At[4][2], B0[2][2], B1[2][2];
    const char* cA = uptr((const char*)g.A + S.a_off(cur)); const char* cB = uptr((const char*)g.Bt + S.b_off(cur));
    S.a_ready(cur);
    if constexpr (SP2) {
        PG8_STAGE(PG8_SB(0, 0), cB, voffB); PG8_STAGE(PG8_SB(0, 1), cB + hstepB, voffB); PG8_STAGE(PG8_SA(0, 0), cA, voffA); PG8_STAGE(PG8_SA(0, 1), cA + hstepA, voffA);
        if (wr == 1) PG8_BAR;
        PG8_WAIT_V(2); PG8_BAR;
        PG8_STAGE(PG8_SB(1, 0), cB + kstep, voffB); PG8_STAGE(PG8_SA(1, 0), cA + kstep, voffA); PG8_STAGE(PG8_SB(1, 1), cB + hstepB + kstep, voffB);
        PG8_WAIT_V(6); PG8_BAR;
    } else {
        PG8_STAGE(PG8_SB(0, 0), cB, voffB); PG8_STAGE(PG8_SA(0, 0), cA, voffA); PG8_STAGE(PG8_SB(0, 1), cB + hstepB, voffB); PG8_STAGE(PG8_SA(0, 1), cA + hstepA, voffA);
        if (wr == 1) PG8_BAR;
        PG8_WAIT_V(4); PG8_BAR;
        PG8_STAGE(PG8_SB(1, 0), cB + kstep, voffB); PG8_STAGE(PG8_SA(1, 0), cA + kstep, voffA); PG8_STAGE(PG8_SB(1, 1), cB + hstepB + kstep, voffB);
        PG8_WAIT_V(6); PG8_BAR;
    }
    for (;;) {
        const bool has_next = S.next(ui + 1, nxt);
        const char* nA = uptr(has_next ? (const char*)g.A + S.a_off(nxt) : cA); const char* nB = uptr(has_next ? (const char*)g.Bt + S.b_off(nxt) : cB);
        for (int t = 0; t < nt; t += 2) {
            const bool last = (t == nt - 2);
            const char* a1 = cA + (size_t)(t + 1) * kstep;
            const char* a2 = last ? nA : cA + (size_t)(t + 2) * kstep; const char* b2 = last ? nB : cB + (size_t)(t + 2) * kstep;
            const char* a3 = a2 + kstep; const char* b3 = b2 + kstep;
            if (last && has_next) S.a_ready(nxt);
            if constexpr (SP2) {
            PG8_LDB(B0, 0, 0); PG8_LDB(B1, 0, 1); PG8_SCHED; PG8_LDA(At, 0, 0); PG8_STAGE(PG8_SA(1, 1), a1 + hstepA, voffA);
            PG8_WAIT_V(8); PG8_WAIT_L(0); PG8_BAR; PG8_MMA(0, 0, At, B0); PG8_MMA(0, 1, At, B1); PG8_BAR; PG8_SCHED;
            PG8_LDA(At, 0, 1); PG8_STAGE(PG8_SB(0, 0), b2, voffB); PG8_STAGE(PG8_SB(0, 1), b2 + hstepB, voffB); PG8_STAGE(PG8_SA(0, 0), a2, voffA);
            PG8_WAIT_V(8); PG8_WAIT_L(0); PG8_BAR; PG8_MMA(1, 0, At, B0); PG8_MMA(1, 1, At, B1); PG8_BAR; PG8_SCHED;
            PG8_LDB(B0, 1, 0); PG8_LDB(B1, 1, 1); PG8_SCHED; PG8_LDA(At, 1, 0); PG8_STAGE(PG8_SA(0, 1), a2 + hstepA, voffA);
            PG8_WAIT_V(8); PG8_WAIT_L(0); PG8_BAR; PG8_MMA(0, 0, At, B0); PG8_MMA(0, 1, At, B1); PG8_BAR; PG8_SCHED;
            PG8_LDA(At, 1, 1); PG8_STAGE(PG8_SB(1, 0), b3, voffB); PG8_STAGE(PG8_SB(1, 1), b3 + hstepB, voffB); PG8_STAGE(PG8_SA(1, 0), a3, voffA);
            PG8_WAIT_V(8); PG8_WAIT_L(0); PG8_BAR; PG8_MMA(1, 0, At, B0); PG8_MMA(1, 1, At, B1); PG8_BAR; PG8_SCHED;
            } else {
            PG8_LDB(B0, 0, 0); PG8_SCHED; PG8_LDA(At, 0, 0); PG8_STAGE(PG8_SA(1, 1), a1 + hstepA, voffA);
            PG8_WAIT_L(8); PG8_BAR; PG8_WAIT_L(0); PG8_MMA(0, 0, At, B0); PG8_BAR; PG8_SCHED;
            PG8_LDB(B1, 0, 1); PG8_STAGE(PG8_SB(0, 0), b2, voffB);
            PG8_BAR; PG8_WAIT_L(0); PG8_MMA(0, 1, At, B1); PG8_BAR;
            PG8_LDA(At, 0, 1); PG8_STAGE(PG8_SA(0, 0), a2, voffA);
            PG8_BAR; PG8_WAIT_L(0); PG8_MMA(1, 0, At, B0); PG8_BAR; PG8_SCHED;
            PG8_STAGE(PG8_SB(0, 1), b2 + hstepB, voffB);
            PG8_WAIT_V(6); PG8_BAR; PG8_MMA(1, 1, At, B1); PG8_BAR;
            PG8_LDB(B0, 1, 0); PG8_SCHED; PG8_LDA(At, 1, 0); PG8_STAGE(PG8_SA(0, 1), a2 + hstepA, voffA);
            PG8_WAIT_L(8); PG8_BAR; PG8_WAIT_L(0); PG8_MMA(0, 0, At, B0); PG8_BAR; PG8_SCHED;
            PG8_LDB(B1, 1, 1); PG8_STAGE(PG8_SB(1, 0), b3, voffB);
            PG8_BAR; PG8_WAIT_L(0); PG8_MMA(0, 1, At, B1); PG8_BAR;
            PG8_LDA(At, 1, 1); PG8_STAGE(PG8_SA(1, 0), a3, voffA);
            PG8_BAR; PG8_WAIT_L(0); PG8_MMA(1, 0, At, B0); PG8_BAR; PG8_SCHED;
            PG8_STAGE(PG8_SB(1, 1), b3 + hstepB, voffB);
            PG8_WAIT_V(6); PG8_BAR; PG8_MMA(1, 1, At, B1); PG8_BAR;
            }
        }
        if constexpr (ALIGN_EPI) { if (wr == 0) PG8_BAR; }
        if constexpr (!Epi::AFTER_DRAIN) { int fr_ = fr, fq_ = fq; asm volatile("" : "+v"(fr_), "+v"(fq_)); E(acc, cur, wr, wc, fr_, fq_); S.done(cur); }
        if (!has_next) break;
#pragma unroll
        for (int a = 0; a < 2; ++a)
#pragma unroll
            for (int b = 0; b < 2; ++b)
#pragma unroll
                for (int m = 0; m < 4; ++m)
#pragma unroll
                    for (int n = 0; n < 2; ++n) acc[a][b][m][n] = (f32x4){0.f, 0.f, 0.f, 0.f};
        cur = nxt; cA = nA; cB = nB; ++ui;
        if constexpr (ALIGN_EPI) { if (wr == 1) PG8_BAR; }
    }
    PG8_WAIT_V(0);
    if constexpr (!ALIGN_EPI) { if (wr == 0) PG8_BAR; }
    PG8_BAR;
    if constexpr (Epi::AFTER_DRAIN) { E.fused(acc, cur, wr, wc, fr, fq, lds, wid, lane); S.done(cur); }
#undef PG8_SA
#undef PG8_SB
#undef PG8_STAGE
#undef PG8_LDA
#undef PG8_LDB
#undef PG8_MMA
#undef PG8_WAIT_V
#undef PG8_WAIT_L
#undef PG8_BAR
#undef PG8_SCHED
}
}


namespace fa {
using bf16 = unsigned short;
constexpr int   D = 128, NW = 8, QBLK = 32, KVBLK = 64;
constexpr float SCALE = 0.088388347648318440f;
constexpr float THR = 8.f;
constexpr int SDEPTH = 1;
constexpr int LDQ = 1024, LDK = 256, LDO = 1024;
constexpr size_t SHM_V = KVBLK * D * 2, SHM_K = KVBLK * D * 2, SHM_ATTN = 2 * SHM_V + 2 * SHM_K + NW * 64 * 4;
using bf16x8 = __attribute__((ext_vector_type(8))) short;
using s16x4  = __attribute__((ext_vector_type(4))) short;
using f32x16 = __attribute__((ext_vector_type(16))) float;
using f32x8  = __attribute__((ext_vector_type(8))) float;
using u32x4  = __attribute__((ext_vector_type(4))) unsigned;
#define KSWZ(row, colB) ((row) * 256 + ((colB) ^ (((row) & 7) << 4)))
#define SBAR() __builtin_amdgcn_sched_barrier(0)
__device__ __forceinline__ int crow(int r, int hi) { return (r & 3) + 8 * (r >> 2) + 4 * hi; }
__device__ __forceinline__ unsigned cvtpk(float lo, float hi) {
  unsigned r; asm volatile("v_cvt_pk_bf16_f32 %0, %1, %2" : "=v"(r) : "v"(lo), "v"(hi)); return r;
}
template <typename TIn> struct Stage;
template <> struct Stage<bf16>  { using T = bf16x8;
  __device__ static __forceinline__ T ld8(const bf16* p) { return *reinterpret_cast<const bf16x8*>(p); }
  __device__ static __forceinline__ bf16x8 tobf(T x) { return x; } };
template <> struct Stage<float> { using T = f32x8;
  __device__ static __forceinline__ T ld8(const float* p) { return *reinterpret_cast<const f32x8*>(p); }
  __device__ static __forceinline__ bf16x8 tobf(T x) {
    u32x4 w = {cvtpk(x[0], x[1]), cvtpk(x[2], x[3]), cvtpk(x[4], x[5]), cvtpk(x[6], x[7])}; return *reinterpret_cast<bf16x8*>(&w); } };

__device__ __forceinline__ void partialSM(f32x16& p0, f32x16& p1, float& m_reg, float& mn, float& alpha) {
  constexpr float C = SCALE * 1.4426950408889634f;
  float pmax = p0[0]; for (int r = 1; r < 16; ++r) pmax = fmaxf(pmax, p0[r]); for (int r = 0; r < 16; ++r) pmax = fmaxf(pmax, p1[r]);
  { auto rr = __builtin_amdgcn_permlane32_swap(__float_as_uint(pmax), __float_as_uint(pmax), false, false);
    pmax = fmaxf(__uint_as_float(rr[0]), __uint_as_float(rr[1])); }
  if (__builtin_expect(__all(pmax - m_reg <= THR / SCALE), 1)) { mn = m_reg; alpha = 1.f; }
  else { mn = fmaxf(m_reg, pmax); alpha = __builtin_amdgcn_exp2f((m_reg - mn) * C); m_reg = mn; }
  float mnC = -mn * C;
  for (int r = 0; r < 16; ++r) p0[r] = fmaf(p0[r], C, mnC); for (int r = 0; r < 16; ++r) p1[r] = fmaf(p1[r], C, mnC);
  for (int r = 0; r < 16; ++r) p0[r] = __builtin_amdgcn_exp2f(p0[r]);
}
__device__ __forceinline__ void finishSM(f32x16& p0, f32x16& p1, float alpha, float& l_reg, bf16x8& pa0, bf16x8& pa1, bf16x8& pa2, bf16x8& pa3) {
  for (int r = 0; r < 16; ++r) p1[r] = __builtin_amdgcn_exp2f(p1[r]);
  float ps = 0; for (int r = 0; r < 16; ++r) ps += p0[r]; for (int r = 0; r < 16; ++r) ps += p1[r];
  { auto rr = __builtin_amdgcn_permlane32_swap(__float_as_uint(ps), __float_as_uint(ps), false, false);
    ps = __uint_as_float(rr[0]) + __uint_as_float(rr[1]); }
  l_reg = l_reg * alpha + ps;
#define PK4(P, BASE, OUT) do { unsigned a0 = cvtpk(P[BASE + 0], P[BASE + 1]), a1 = cvtpk(P[BASE + 2], P[BASE + 3]);   \
    unsigned b0 = cvtpk(P[BASE + 4], P[BASE + 5]), b1 = cvtpk(P[BASE + 6], P[BASE + 7]);                              \
    auto r0 = __builtin_amdgcn_permlane32_swap(a0, b0, false, false); auto r1 = __builtin_amdgcn_permlane32_swap(a1, b1, false, false); \
    u32x4 w = {r0[0], r1[0], r0[1], r1[1]}; OUT = *reinterpret_cast<bf16x8*>(&w); } while (0)
  PK4(p0, 0, pa0); PK4(p0, 8, pa1); PK4(p1, 0, pa2); PK4(p1, 8, pa3);
#undef PK4
}
__device__ __forceinline__ void qkt(f32x16& p0, f32x16& p1, const bf16* Ks, const bf16x8* qr, int r32, int hi) {
  p0 = f32x16{}; p1 = f32x16{};
  for (int d0 = 0; d0 < 8; ++d0) { int cb = (d0 * 16 + hi * 8) * 2;
    bf16x8 b0 = *reinterpret_cast<const bf16x8*>((const char*)Ks + KSWZ(r32, cb));
    bf16x8 b1 = *reinterpret_cast<const bf16x8*>((const char*)Ks + KSWZ(32 + r32, cb));
    p0 = __builtin_amdgcn_mfma_f32_32x32x16_bf16(b0, qr[d0], p0, 0, 0, 0);
    p1 = __builtin_amdgcn_mfma_f32_32x32x16_bf16(b1, qr[d0], p1, 0, 0, 0); }
}
__device__ __forceinline__ int v_st(int k, int c) { const int kk = (k & ~0xC) | ((k & 4) << 1) | ((k & 8) >> 1); return ((kk >> 3) * 4 + (c >> 5)) * 512 + ((kk & 7) * 32 + (c & 31)) * 2; }
__device__ __forceinline__ int v_rd_base(int lane) { return ((lane & 3) << 3) | (((lane >> 2) & 3) << 6) | (((lane >> 4) & 1) << 5) | (((lane >> 5) & 1) << 8); }
constexpr int v_rd_off(int d0, int ks, int half) { return d0 * 512 + ks * 4096 + half * 2048; }
template <int OFF> __device__ __forceinline__ s16x4 tr_read(int vb) {
  s16x4 r; asm volatile("ds_read_b64_tr_b16 %0, %1 offset:%2" : "=&v"(r) : "v"(vb), "i"(OFF) : "memory"); return r;
}
template <int D0> __device__ __forceinline__ void pv_one(f32x16& od, int vb, bf16x8 pa0, bf16x8 pa1, bf16x8 pa2, bf16x8 pa3) {
  const s16x4 l0 = tr_read<v_rd_off(D0, 0, 0)>(vb), h0 = tr_read<v_rd_off(D0, 0, 1)>(vb), l1 = tr_read<v_rd_off(D0, 1, 0)>(vb), h1 = tr_read<v_rd_off(D0, 1, 1)>(vb);
  const s16x4 l2 = tr_read<v_rd_off(D0, 2, 0)>(vb), h2 = tr_read<v_rd_off(D0, 2, 1)>(vb), l3 = tr_read<v_rd_off(D0, 3, 0)>(vb), h3 = tr_read<v_rd_off(D0, 3, 1)>(vb);
  asm volatile("s_waitcnt lgkmcnt(0)" ::: "memory"); SBAR();
#define PK(L, H) (bf16x8){L[0], L[1], L[2], L[3], H[0], H[1], H[2], H[3]}
  od = __builtin_amdgcn_mfma_f32_32x32x16_bf16(pa0, PK(l0, h0), od, 0, 0, 0);
  od = __builtin_amdgcn_mfma_f32_32x32x16_bf16(pa1, PK(l1, h1), od, 0, 0, 0);
  od = __builtin_amdgcn_mfma_f32_32x32x16_bf16(pa2, PK(l2, h2), od, 0, 0, 0);
  od = __builtin_amdgcn_mfma_f32_32x32x16_bf16(pa3, PK(l3, h3), od, 0, 0, 0);
#undef PK
}
__device__ __forceinline__ void pv_d0(f32x16* o, int vb, bf16x8 pa0, bf16x8 pa1, bf16x8 pa2, bf16x8 pa3) {
  pv_one<0>(o[0], vb, pa0, pa1, pa2, pa3); pv_one<1>(o[1], vb, pa0, pa1, pa2, pa3); pv_one<2>(o[2], vb, pa0, pa1, pa2, pa3); pv_one<3>(o[3], vb, pa0, pa1, pa2, pa3);
}

template <typename TQ>
__device__ __forceinline__ void attn_dense_body(const TQ* Qb, const bf16* __restrict__ Kh, const bf16* __restrict__ Vh,
                                                bf16* Ob, int seq, char* lds, int wv) {
  using St = Stage<bf16>; using SQ = Stage<TQ>;
  const int tid = otid(wv), wid = tid >> 6, lane = tid & 63, r32 = lane & 31, hi = lane >> 5;
  bf16* V_lds = (bf16*)lds; bf16* K_lds = (bf16*)(lds + 2 * SHM_V);
  float* ws = (float*)(lds + 2 * SHM_V + 2 * SHM_K) + wid * 64; float* li_l = ws; float* al_l = ws + 32;
  float m_reg = -1e30f, l_reg = 0; f32x16 o[4] = {}; bf16x8 qr[8];
  const TQ* Qw = Qb + (long)(wid * QBLK + r32) * LDQ + hi * 8;
#pragma unroll
  for (int d0 = 0; d0 < 8; ++d0) qr[d0] = SQ::tobf(SQ::ld8(Qw + d0 * 16));
  const int sr = tid >> 4, sc = (tid & 15) * 8, vst0 = v_st(sr, sc), vst1 = v_st(32 + sr, sc);
  const int vb0 = (int)(uintptr_t)V_lds + v_rd_base(lane);
  struct { typename St::T vs0, vs1, ks0, ks1; } sr_[SDEPTH];
#define SLOAD(i, k0) do { sr_[i].vs0 = St::ld8(&Vh[(long)((k0) + sr) * LDK + sc]); sr_[i].vs1 = St::ld8(&Vh[(long)((k0) + 32 + sr) * LDK + sc]); \
    sr_[i].ks0 = St::ld8(&Kh[(long)((k0) + sr) * LDK + sc]); sr_[i].ks1 = St::ld8(&Kh[(long)((k0) + 32 + sr) * LDK + sc]); } while (0)
#define SWRITE(b, i) do { *(bf16x8*)((char*)V_lds + (b) * SHM_V + vst0) = St::tobf(sr_[i].vs0);          \
    *(bf16x8*)((char*)V_lds + (b) * SHM_V + vst1) = St::tobf(sr_[i].vs1); int kc = sc * 2;               \
    *(bf16x8*)((char*)K_lds + (b) * SHM_K + KSWZ(sr, kc)) = St::tobf(sr_[i].ks0);                       \
    *(bf16x8*)((char*)K_lds + (b) * SHM_K + KSWZ(32 + sr, kc)) = St::tobf(sr_[i].ks1); } while (0)
#define SWAIT() do { if constexpr (SDEPTH == 2) asm volatile("s_waitcnt vmcnt(4)" ::: "memory"); else asm volatile("s_waitcnt vmcnt(0)" ::: "memory"); } while (0)
#define RESC(a) do { if (__any((a) < 1.f)) { if (hi == 0) al_l[r32] = (a); asm volatile("s_waitcnt lgkmcnt(0)" ::: "memory"); \
    for (int d = 0; d < 4; ++d) for (int r = 0; r < 16; ++r) o[d][r] *= al_l[crow(r, hi)]; } } while (0)
  f32x16 pA0, pA1, pB0, pB1; float mnA, mnB, alA, alB; bf16x8 pa0, pa1, pa2, pa3; const int NT = seq / KVBLK;
  constexpr int SE = 0, SO = SDEPTH - 1;
  SLOAD(SE, 0); asm volatile("s_waitcnt vmcnt(0)" ::: "memory"); SWRITE(0, SE); __syncthreads();
  qkt(pA0, pA1, K_lds, qr, r32, hi); partialSM(pA0, pA1, m_reg, mnA, alA);
  SLOAD(SO, KVBLK); if constexpr (SDEPTH == 2) { if (2 < NT) SLOAD(SE, 2 * KVBLK); }
  SWAIT(); SWRITE(1, SO); __syncthreads();
  for (int j = 1; j + 1 < NT; j += 2) {
    SBAR(); qkt(pB0, pB1, (bf16*)((char*)K_lds + SHM_K), qr, r32, hi);
    finishSM(pA0, pA1, alA, l_reg, pa0, pa1, pa2, pa3); SBAR();
    SLOAD(SO, (j + SDEPTH) * KVBLK); SBAR();
    pv_d0(o, vb0, pa0, pa1, pa2, pa3); partialSM(pB0, pB1, m_reg, mnB, alB);
    __syncthreads(); SWAIT(); SWRITE(0, SE);
    RESC(alB); __syncthreads();
    SBAR(); qkt(pA0, pA1, K_lds, qr, r32, hi);
    finishSM(pB0, pB1, alB, l_reg, pa0, pa1, pa2, pa3); SBAR();
    if (SDEPTH == 1 || j + 3 < NT) SLOAD(SE, (j + 1 + SDEPTH) * KVBLK); SBAR();
    pv_d0(o, vb0 + (int)SHM_V, pa0, pa1, pa2, pa3); partialSM(pA0, pA1, m_reg, mnA, alA);
    __syncthreads(); SWAIT(); SWRITE(1, SO);
    RESC(alA); __syncthreads();
  }
  SBAR(); qkt(pB0, pB1, (bf16*)((char*)K_lds + SHM_K), qr, r32, hi);
  finishSM(pA0, pA1, alA, l_reg, pa0, pa1, pa2, pa3); SBAR();
  pv_d0(o, vb0, pa0, pa1, pa2, pa3); partialSM(pB0, pB1, m_reg, mnB, alB);
  __syncthreads(); RESC(alB);
  finishSM(pB0, pB1, alB, l_reg, pa0, pa1, pa2, pa3); SBAR();
  pv_d0(o, vb0 + (int)SHM_V, pa0, pa1, pa2, pa3);
  if (hi == 0) li_l[r32] = l_reg; asm volatile("s_waitcnt lgkmcnt(0)" ::: "memory");
  float rli[16];
#pragma unroll
  for (int r = 0; r < 16; ++r) rli[r] = __builtin_amdgcn_rcpf(li_l[crow(r, hi)]);
  bf16* Ow = Ob + (long)(wid * QBLK) * LDO;
#pragma unroll
  for (int r = 0; r < 16; ++r) { int orow = crow(r, hi);
    for (int d0 = 0; d0 < 4; ++d0) Ow[(long)orow * LDO + d0 * 32 + r32] = f2bf(o[d0][r] * rli[r]); }
#undef SLOAD
#undef SWRITE
#undef SWAIT
#undef RESC
}

}

__device__ __forceinline__ void attn_phase(bf16_t* QA, const bf16_t* KA, const bf16_t* VA, bf16_t* OA, char* lds, int vcu, int G, int wv) {
    for (int u = vcu, it_ = 0; u < 384; u = (G == 256 ? (vcu >= 128 && it_ == 0 ? 256 + (vcu - 128) : 384) : u + G), ++it_) {
        bf16_t* Q; const bf16_t* K; const bf16_t* V; int seq;
        if (u < 256) { const int grp = u >> 6, b = grp >> 1, kvh = grp & 1, g = (u >> 4) & 3, qb = u & 15, head = kvh * 4 + g;
            Q = QA + (size_t)(NCTX + b * TLAT + qb * 256) * 1024 + head * 128; const size_t ko = (size_t)(NCTX + b * KV_ROWS_LAT) * 256 + kvh * 128; K = KA + ko; V = VA + ko; seq = KV_ROWS_LAT; }
        else { const int c = u - 256, s = c >> 3, head = c & 7;
            Q = QA + (size_t)(s * 256) * 1024 + head * 128; const size_t ko = (size_t)(s * 256) * 256 + (head >> 2) * 128; K = KA + ko; V = VA + ko; seq = TCTX; }
        fa::attn_dense_body<fa::bf16>(Q, K, V, OA + (Q - QA), seq, lds, wv);
        __syncthreads();
    }
}
namespace hu {
using pg8::bf16x8; using pg8::f32x4; using pg8::u32x4; using pg8::u32x2;
constexpr int KT_STRIDE = 528, BT_STRIDE = 144;
constexpr int L_KT = 0, L_BT = 64 * KT_STRIDE, L_A = L_BT + 256 * BT_STRIDE, L_N = L_A + 256, L_DEN = L_N + 1024, L_HF = L_DEN + 512, L_END = L_HF + 65536;
__device__ __forceinline__ void hunit(int u, unsigned char* ws, const float* __restrict__ gm, unsigned char* lds, int wv) {
#define HW_(T, boff) (*(const T*)(ws + (unsigned)(boff)))
    const int tid = otid(wv), lane = tid & 63, w = __builtin_amdgcn_readfirstlane(tid >> 6), q = lane & 15, g = lane >> 4;
    int h, blk, rowbase, chain0 = 0; bool lat;
    if (u < 256) { lat = true; const int b = u >> 7; h = (u >> 5) & 3; blk = u & 31; rowbase = NCTX + b * TLAT; chain0 = b * 8; }
    else { lat = false; const int c2 = u - 256; h = (c2 >> 1) & 3; blk = c2 & 1; rowbase = (c2 >> 3) * TCTX; }
    const int c = blk >> 1, half = blk & 1, cstart = rowbase + c * 256, R0 = cstart + half * 128, qrel = half * 128 + 16 * w + q;
    const int myrow = R0 + 16 * w + q;
    const int arow0 = R0 + 16 * w + 4 * g;
    bf16x8 qf[8];
#pragma unroll
    for (int s = 0; s < 8; ++s) qf[s] = HW_(bf16x8, WS_QM + (unsigned)(myrow * 1024 + h * 256 + 32 * s + 8 * g) * 2u);
    f32x4 O[16];
    float* a_s = (float*)(lds + L_A); float* n_s = (float*)(lds + L_N); float* den_s = (float*)(lds + L_DEN) + w * 16;
#pragma unroll 1
    for (int dir = 0; dir < 2; ++dir) {
        const int dirh = dir * 4 + h; const unsigned sco = (unsigned)dirh * MTOK;
        const float mc = lat ? HW_(float, WS_CH + (unsigned)(CH_MC + (chain0 + dirh) * 16 + c) * 4u) : 0.f;
        const float Mq = fmaxf(mc, HW_(float, WS_SC + (unsigned)(SC_P * SC_STRIDE + sco + myrow) * 4u)), flq = __expf(-(HW_(float, WS_SC + (unsigned)(SC_LB * SC_STRIDE + sco + myrow) * 4u) + Mq));
#pragma unroll
        for (int eb = 0; eb < 16; ++eb) O[eb] = (f32x4){0.f, 0.f, 0.f, 0.f};
        float den = 0.f;
        if (lat) {
            const unsigned slot = (unsigned)(chain0 + dirh) * 16 + c, cso = WS_KFT + slot * 131072u;
#pragma unroll
            for (int ds = 0; ds < 4; ++ds) {
                { const unsigned cpo = cso + (unsigned)((tid >> 1) * 256 + (tid & 1) * 32 + 64 * ds) * 2u; unsigned char* dp = lds + L_BT + (tid >> 1) * BT_STRIDE + (tid & 1) * 64;
#pragma unroll
                  for (int i = 0; i < 4; ++i) *(u32x4*)(dp + i * 16) = HW_(u32x4, cpo + i * 16); }
                if (ds == 0 && tid < 256) n_s[tid] = HW_(float, WS_NT + (slot * 256 + tid) * 4u);
                __syncthreads();
#pragma unroll
                for (int eb = 0; eb < 16; ++eb)
#pragma unroll
                    for (int ks = 0; ks < 2; ++ks) { const bf16x8 B = *(const bf16x8*)(lds + L_BT + (16 * eb + q) * BT_STRIDE + (32 * ks + 8 * g) * 2);
                        O[eb] = __builtin_amdgcn_mfma_f32_16x16x32_bf16(qf[2 * ds + ks], B, O[eb], 0, 0, 0); if ((eb & 3) == 3 && ks == 1) __builtin_amdgcn_sched_barrier(0); }
                if (ds == 0) {
                    float dn = 0.f;
#pragma unroll
                    for (int s = 0; s < 8; ++s)
#pragma unroll
                        for (int j = 0; j < 8; ++j) dn += __uint_as_float(((unsigned)(unsigned short)qf[s][j]) << 16) * n_s[32 * s + 8 * g + j];
                    __builtin_amdgcn_sched_barrier(0);
                    dn += shx(dn, 16, lane); dn += shx(dn, 32, lane);
                    den = dn * __expf(mc - Mq);
                }
                __syncthreads();
            }
            f32x4 wi = HW_(f32x4, WS_SC + (unsigned)(SC_P * SC_STRIDE + sco + arow0) * 4u);
#pragma unroll
            for (int r = 0; r < 4; ++r) wi[r] = __expf(mc - fmaxf(mc, wi[r]));
#pragma unroll
            for (int eb = 0; eb < 16; ++eb) O[eb] = O[eb] * wi;
        }
        const int jt0 = dir == 0 ? 0 : (half ? 2 : 0), jt1 = dir == 0 ? (half ? 3 : 1) : 3;
        float dsum = 0.f;
#pragma unroll 1
        for (int jt = jt0; jt <= jt1; ++jt) {
            const int KR0 = cstart + 64 * jt;
            { const unsigned kpo = WS_KM + (unsigned)((KR0 + (tid >> 3)) * 1024 + h * 256 + (tid & 7) * 8) * 2u; unsigned char* kd = lds + L_KT + (tid >> 3) * KT_STRIDE + (tid & 7) * 16;
              const unsigned vpo = WS_VT + (unsigned)((h * 256 + (tid >> 1)) * MTOK + KR0 + (tid & 1) * 32) * 2u; unsigned char* vd = lds + L_BT + (tid >> 1) * BT_STRIDE + (tid & 1) * 64;
#pragma unroll
              for (int i = 0; i < 4; ++i) { *(u32x4*)(kd + i * 128) = HW_(u32x4, kpo + i * 128); *(u32x4*)(vd + i * 16) = HW_(u32x4, vpo + i * 16); } }
            if (tid < 64) a_s[tid] = HW_(float, WS_SC + (unsigned)(SC_A * SC_STRIDE + sco + KR0 + tid) * 4u);
            __syncthreads();
            const int rlo = half * 128 + 16 * w, rhi = rlo + 15, klo = 64 * jt, khi = klo + 63;
            const bool active = dir == 0 ? (klo <= rhi) : (khi >= rlo);
            if (active) {
                f32x4 st[4];
#pragma unroll
                for (int kb = 0; kb < 4; ++kb) { st[kb] = (f32x4){0.f, 0.f, 0.f, 0.f};
#pragma unroll
                    for (int s = 0; s < 8; ++s) { const bf16x8 A = *(const bf16x8*)(lds + L_KT + (16 * kb + q) * KT_STRIDE + (32 * s + 8 * g) * 2);
                        st[kb] = __builtin_amdgcn_mfma_f32_16x16x32_bf16(A, qf[s], st[kb], 0, 0, 0); } }
#pragma unroll
                for (int kb = 0; kb < 4; ++kb) { const f32x4 av = *(const f32x4*)(a_s + 16 * kb + 4 * g);
#pragma unroll
                    for (int r = 0; r < 4; ++r) { const int krel = klo + 16 * kb + 4 * g + r; const bool vis = dir == 0 ? (krel <= qrel) : (krel >= qrel);
                        const float p = vis ? st[kb][r] * __builtin_amdgcn_exp2f((av[r] - Mq) * 1.4426950408889634f) : 0.f; st[kb][r] = p; dsum += p; } }
#pragma unroll
                for (int s2 = 0; s2 < 2; ++s2) { u32x4 pw; pw.x = pg8::cvt_pk_bf16(st[2 * s2][0], st[2 * s2][1]); pw.y = pg8::cvt_pk_bf16(st[2 * s2][2], st[2 * s2][3]);
                    pw.z = pg8::cvt_pk_bf16(st[2 * s2 + 1][0], st[2 * s2 + 1][1]); pw.w = pg8::cvt_pk_bf16(st[2 * s2 + 1][2], st[2 * s2 + 1][3]);
                    const bf16x8 pa = __builtin_bit_cast(bf16x8, pw);
#pragma unroll
                    for (int eb = 0; eb < 16; ++eb) { const unsigned char* bp = lds + L_BT + (16 * eb + q) * BT_STRIDE + (32 * s2 + 4 * g) * 2;
                        const u32x2 lo = *(const u32x2*)bp, hi = *(const u32x2*)(bp + 32); u32x4 bw; bw.x = lo.x; bw.y = lo.y; bw.z = hi.x; bw.w = hi.y;
                        O[eb] = __builtin_amdgcn_mfma_f32_16x16x32_bf16(pa, __builtin_bit_cast(bf16x8, bw), O[eb], 0, 0, 0); if ((eb & 3) == 3) __builtin_amdgcn_sched_barrier(0); } }
            }
            __syncthreads();
        }
        dsum += shx(dsum, 16, lane); dsum += shx(dsum, 32, lane);
        den += dsum;
        if (g == 0) den_s[q] = 1.f / fmaxf(fabsf(den), flq);
        __syncthreads();
        const f32x4 rinv = *(const f32x4*)(den_s + 4 * g);
        __syncthreads();
        if (dir == 0) {
#pragma unroll
            for (int eb = 0; eb < 16; ++eb) { const f32x4 v = O[eb] * rinv; u32x2 pk; pk.x = pg8::cvt_pk_bf16(v[0], v[1]); pk.y = pg8::cvt_pk_bf16(v[2], v[3]); *(u32x2*)(lds + L_HF + eb * 4096 + tid * 8) = pk; }
        } else {
#pragma unroll
            for (int eb = 0; eb < 16; ++eb) O[eb] = O[eb] * rinv + pg8::bf4_to_f32(*(const u32x2*)(lds + L_HF + eb * 4096 + tid * 8));
        }
    }
    f32x4 ss = (f32x4){0.f, 0.f, 0.f, 0.f};
#pragma unroll
    for (int eb = 0; eb < 16; ++eb) ss += O[eb] * O[eb];
#pragma unroll
    for (int off = 1; off < 16; off <<= 1) { ss[0] += shx(ss[0], off, lane); ss[1] += shx(ss[1], off, lane); ss[2] += shx(ss[2], off, lane); ss[3] += shx(ss[3], off, lane); }
    f32x4 rr;
#pragma unroll
    for (int r = 0; r < 4; ++r) rr[r] = 1.f / sqrtf(ss[r] * (1.f / 256.f) + EPS);
#pragma unroll
    for (int eb = 0; eb < 16; ++eb) { const int col = h * 256 + 16 * eb + q; const float gg = gm[col];
#pragma unroll
        for (int r = 0; r < 4; ++r) { const unsigned i2 = (unsigned)((arow0 + r) * 1024 + col) * 2u; *(bf16_t*)(ws + (unsigned)(WS_QM + i2)) = f2bf(O[eb][r] * rr[r] * gg * bf2f(HW_(bf16_t, WS_OM + i2))); }
        if ((eb & 1) == 1) __builtin_amdgcn_sched_barrier(0); }
}
#undef HW_
}

struct P {
    const float *x_prompt, *x_sample, *cache_k, *cache_v, *state_C, *state_n, *state_m, *c, *c_ctx, *w_mod, *b_mod, *w_in, *b_gates, *mlstm_g, *q_g, *k_g,
                *w_bm, *w_ba, *w_out, *ln1_g, *ln1_b, *w_up, *w_down, *ln2_g, *ln2_b;
    float* out; unsigned char* ws;
};
__device__ __forceinline__ void wt_item(const float* __restrict__ W, bf16_t* __restrict__ WT, int ldw, int col0, int K, int drow0, int nb, int kb, float* scr, int lane) {
    const int k0 = 64 * kb, n0 = 32 * nb; const float* wp = W + (size_t)(k0 + (lane >> 5)) * ldw + col0 + n0 + (lane & 31);
#pragma unroll 8
    for (int i = 0; i < 32; ++i) scr[(2 * i + (lane >> 5)) * 33 + (lane & 31)] = wp[(size_t)(2 * i) * ldw];
    asm volatile("s_waitcnt lgkmcnt(0)" ::: "memory");
    const int c = lane & 7;
#pragma unroll
    for (int j = 0; j < 4; ++j) { const int n = (lane >> 3) + 8 * j; const float* sp = scr + (8 * c) * 33 + n;
        pg8::u32x4 o; o.x = pg8::cvt_pk_bf16(sp[0], sp[33]); o.y = pg8::cvt_pk_bf16(sp[66], sp[99]); o.z = pg8::cvt_pk_bf16(sp[132], sp[165]); o.w = pg8::cvt_pk_bf16(sp[198], sp[231]);
        *(pg8::u32x4*)(WT + (size_t)(drow0 + n0 + n) * K + k0 + 8 * c) = o; }
    asm volatile("s_waitcnt lgkmcnt(0)" ::: "memory");
}
__device__ __forceinline__ void ph_weights(const float* w_in, const float* w_bm, const float* w_ba, const float* w_out, const float* w_up, const float* w_down, unsigned char* ws, unsigned char* lds, int bx, int G, int wv) {
    bf16_t* WinT = (bf16_t*)(ws + WS_WIN); const int lane = otid(wv) & 63; float* scr = (float*)lds + wv * (64 * 33);
    for (int it = bx * 8 + wv; it < 9472; it += G * 8) {
        int r = it;
        if (r < 512) { wt_item(w_in, WinT, DIN, C_QM, DM, R_QM, r & 31, r >> 5, scr, lane); continue; } r -= 512;
        if (r < 512) { wt_item(w_in, WinT, DIN, C_OM, DM, R_OM, r & 31, r >> 5, scr, lane); continue; } r -= 512;
        if (r < 768) { wt_item(w_in, WinT, DIN, C_QA, DM, R_QA, r % 48, r / 48, scr, lane); continue; } r -= 768;
        if (r < 1024) { wt_item(w_in, WinT, DIN, C_KM, DM, R_KM, r & 63, r >> 6, scr, lane); continue; } r -= 1024;
        if (r < 1024) { wt_item(w_in, WinT, DIN, C_GM, DM, R_GM, r & 63, r >> 6, scr, lane); continue; } r -= 1024;
        if (r < 512) { wt_item(w_bm, (bf16_t*)(ws + WS_WBM), DM, 0, DM, 0, r & 31, r >> 5, scr, lane); continue; } r -= 512;
        if (r < 512) { wt_item(w_ba, (bf16_t*)(ws + WS_WBA), DM, 0, DM, 0, r & 31, r >> 5, scr, lane); continue; } r -= 512;
        if (r < 512) { wt_item(w_out, (bf16_t*)(ws + WS_WOUT), DM, 0, DM, 0, r & 31, r >> 5, scr, lane); continue; } r -= 512;
        if (r < 2048) { wt_item(w_up, (bf16_t*)(ws + WS_WUP), DFF, 0, DM, 0, r & 127, r >> 7, scr, lane); continue; } r -= 2048;
        wt_item(w_down, (bf16_t*)(ws + WS_WDN), DM, 0, DFF, 0, r & 31, r >> 5, scr, lane);
    }
    __syncthreads();
}
__device__ __forceinline__ void ph_mod(const float* __restrict__ c, const float* __restrict__ c_ctx, const float* __restrict__ w_mod, const float* __restrict__ b_mod, float* __restrict__ MOD, unsigned char* lds, int bx, int G, int wv) {
    if (bx >= 96) return;
    const int tid = otid(wv), lane = tid & 63, w = tid >> 6; float* sl = (float*)lds; float* red = sl + 3072;
    for (int i = tid; i < 3072; i += 512) { const float x = i < 1024 ? c_ctx[i] : c[i - 1024]; sl[i] = x * sigmoidf_(x); }
    __syncthreads();
    for (int j = bx; j < 96; j += G) {
        const int n = j * 64 + lane; float a0 = 0.f, a1 = 0.f, a2 = 0.f; const float* wp = w_mod + (size_t)(w * 128) * 6144 + n;
#pragma unroll 8
        for (int kk = 0; kk < 128; ++kk) { const float wvv = wp[(size_t)kk * 6144]; const int k = w * 128 + kk; a0 += sl[k] * wvv; a1 += sl[1024 + k] * wvv; a2 += sl[2048 + k] * wvv; }
        red[(w * 3 + 0) * 64 + lane] = a0; red[(w * 3 + 1) * 64 + lane] = a1; red[(w * 3 + 2) * 64 + lane] = a2;
        __syncthreads();
        if (tid < 192) { const int r = tid >> 6; float sacc = 0.f;
#pragma unroll
            for (int ww = 0; ww < 8; ++ww) sacc += red[(ww * 3 + r) * 64 + lane];
            MOD[r * 6144 + n] = sacc + b_mod[n]; }
        __syncthreads();
    }
}
__device__ __forceinline__ void ph_cache(const float* __restrict__ cache_k, const float* __restrict__ cache_v, bf16_t* __restrict__ KA, bf16_t* __restrict__ VA, int bx, int G, int wv) {
    for (int idx = bx * 512 + otid(wv); idx < 2 * 256 * 256; idx += G * 512) { const int b = idx >> 16, j = (idx >> 8) & 255, col = idx & 255;
        const size_t dst = (size_t)(NCTX + b * KV_ROWS_LAT + TLAT + j) * 256 + col; KA[dst] = f2bf(cache_k[idx]); VA[dst] = f2bf(cache_v[idx]); }
}
__device__ __forceinline__ void ph_hgates(const float* __restrict__ x_prompt, const float* __restrict__ x_sample, const float* __restrict__ w_in, const float* __restrict__ b_gates, const float* __restrict__ MOD,
                                          bf16_t* __restrict__ HB, float* __restrict__ gates, unsigned char* lds, int bx, int G, int wv) {
    const int tid = otid(wv), lane = tid & 63, w = tid >> 6; float* Wg = (float*)lds;
    for (int idx = tid; idx < 16384; idx += 512) { const int k = idx >> 4, i = idx & 15; Wg[i * 1024 + k] = w_in[(size_t)k * DIN + C_GATES + i]; }
    __syncthreads();
    const float bg = b_gates[lane >> 2];
    for (int row = bx * 8 + w; row < MTOK; row += G * 8) {
        const float* x = xrow_ptr(x_prompt, x_sample, row); const float* md = MOD + mod_index(row) * 6144;
        float g[16];
#pragma unroll
        for (int i = 0; i < 16; ++i) g[i] = 0.f;
#pragma unroll 1
        for (int i = 0; i < 4; ++i) { const int k = 4 * lane + 256 * i; const f32x4 xv = *(const f32x4*)(x + k), sc = *(const f32x4*)(md + 1024 + k), sh = *(const f32x4*)(md + k);
            const f32x4 hv = xv * (sc + 1.f) + sh;
            pg8::u32x2 pk; pk.x = pg8::cvt_pk_bf16(hv[0], hv[1]); pk.y = pg8::cvt_pk_bf16(hv[2], hv[3]); *(pg8::u32x2*)(HB + (size_t)row * DM + k) = pk;
#pragma unroll
            for (int gi = 0; gi < 16; ++gi) { const f32x4 wr = *(const f32x4*)(Wg + gi * 1024 + k); g[gi] += (hv[0] * wr[0] + hv[1] * wr[1]) + (hv[2] * wr[2] + hv[3] * wr[3]); } }
        float a8[8], a4[4], a2[2], a1;
        { const bool hi = (lane & 32) != 0;
#pragma unroll
          for (int i = 0; i < 8; ++i) { const float snd = hi ? g[i] : g[8 + i], kp = hi ? g[8 + i] : g[i]; a8[i] = kp + shx(snd, 32, lane); } }
        { const bool hi = (lane & 16) != 0;
#pragma unroll
          for (int i = 0; i < 4; ++i) { const float snd = hi ? a8[i] : a8[4 + i], kp = hi ? a8[4 + i] : a8[i]; a4[i] = kp + shx(snd, 16, lane); } }
        { const bool hi = (lane & 8) != 0;
#pragma unroll
          for (int i = 0; i < 2; ++i) { const float snd = hi ? a4[i] : a4[2 + i], kp = hi ? a4[2 + i] : a4[i]; a2[i] = kp + shx(snd, 8, lane); } }
        { const bool hi = (lane & 4) != 0; const float snd = hi ? a2[0] : a2[1], kp = hi ? a2[1] : a2[0]; a1 = kp + shx(snd, 4, lane); }
        a1 += shx(a1, 2, lane); a1 += shx(a1, 1, lane);
        if ((lane & 3) == 0) gates[(size_t)row * 16 + (lane >> 2)] = a1 + bg;
    }
    __syncthreads();
}
__device__ __forceinline__ void ph_scan(const float* __restrict__ gates, float* __restrict__ SC, float* __restrict__ CH, float* __restrict__ oM, int bx, int G, int wv) {
    const int tid_ = otid(wv), lane = tid_ & 63;
    for (int task = bx * 8 + (tid_ >> 6); task < 384; task += G * 8) {
        int dirh, tok0, chainc;
        const bool ctx = task < 128;
        if (ctx) { dirh = task & 7; tok0 = (task >> 3) * TCTX; chainc = 0; }
        else { const int l = task - 128, c = l & 15, ch = l >> 4; dirh = ch & 7; tok0 = NCTX + (ch >> 3) * TLAT + c * 256; chainc = ch * 16 + c; }
        const int dir = dirh >> 2, h = dirh & 3;
        float ig[4], lb[4], a[4], pm_[4]; int tok[4]; float run = 0.f;
#pragma unroll
        for (int e = 0; e < 4; ++e) { const int p = 4 * lane + e; tok[e] = dir ? tok0 + 255 - p : tok0 + p;
            ig[e] = gates[(size_t)tok[e] * 16 + dir * 8 + h]; const float fp = gates[(size_t)tok[e] * 16 + dir * 8 + 4 + h];
            const float lf = fminf(fp, 0.f) - log1pf(expf(-fabsf(fp))); run += lf; lb[e] = run; }
        float incl = run;
#pragma unroll
        for (int off = 1; off < 64; off <<= 1) { const float v = shup(incl, off, lane); if (lane >= off) incl += v; }
        const float excl = incl - run, F = rdlane63(incl);
        float lm = -3.0e38f;
#pragma unroll
        for (int e = 0; e < 4; ++e) { lb[e] += excl; a[e] = ig[e] - lb[e]; lm = fmaxf(lm, a[e]); pm_[e] = lm; }
        float inm = lm;
#pragma unroll
        for (int off = 1; off < 64; off <<= 1) { const float v = shup(inm, off, lane); if (lane >= off) inm = fmaxf(inm, v); }
        float exm = shup(inm, 1, lane); if (lane == 0) exm = -3.0e38f;
        const float A = rdlane63(inm);
#pragma unroll
        for (int e = 0; e < 4; ++e) { const size_t idx = (size_t)dirh * MTOK + tok[e];
            SC[SC_A * SC_STRIDE + idx] = a[e]; SC[SC_P * SC_STRIDE + idx] = fmaxf(exm, pm_[e]); SC[SC_WU * SC_STRIDE + idx] = expf(a[e] - A); SC[SC_LB * SC_STRIDE + idx] = lb[e]; }
        if (lane == 0) {
            if (ctx) { const float Mx = fmaxf(0.f, A); CH[CH_BETAC + task] = expf(A - Mx); oM[task] = F + Mx; }
            else { CH[CH_F + chainc] = F; CH[CH_A + chainc] = A; }
        }
    }
}
__device__ __forceinline__ void ph_un(const bf16_t* __restrict__ KT, const float* __restrict__ CH, float* __restrict__ oN, float* __restrict__ UN, int bx, int G, int wv) {
    const int tid_ = otid(wv);
    for (int id = bx * 2 + (tid_ >> 8); id < 368; id += G * 2) { const int d = tid_ & 255;

    int dirh, tok0, slot = 0; const bool ctx = id < 128;
    if (ctx) { dirh = id & 7; tok0 = (id >> 3) * 256; }
    else { const int l = id - 128, b = l / 120, rem = l % 120, ci = rem % 15; dirh = rem / 15; const int c = (dirh >> 2) ? ci + 1 : ci; tok0 = NCTX + b * TLAT + c * 256; slot = (b * 8 + dirh) * 16 + c; }
    const bf16_t* p = KT + (size_t)((dirh >> 2) * 1024 + (dirh & 3) * 256 + d) * MTOK + tok0;
    float s = 0.f;
    for (int t = 0; t < 256; t += 8) { const pg8::u32x4 w = *(const pg8::u32x4*)(p + t);
        s += __uint_as_float(w.x << 16) + __uint_as_float(w.x & 0xffff0000u) + __uint_as_float(w.y << 16) + __uint_as_float(w.y & 0xffff0000u)
           + __uint_as_float(w.z << 16) + __uint_as_float(w.z & 0xffff0000u) + __uint_as_float(w.w << 16) + __uint_as_float(w.w & 0xffff0000u); }
    if (ctx) oN[(size_t)id * 256 + d] = CH[CH_BETAC + id] * s; else UN[(size_t)slot * 256 + d] = s;
    }
}
__device__ __forceinline__ void ph_cscan(const float* __restrict__ sC, const float* __restrict__ sN, const float* __restrict__ sM, const bf16_t* __restrict__ UT, const float* __restrict__ UN, float* __restrict__ CH,
                                         bf16_t* __restrict__ CT, float* __restrict__ NT, int bx, int G, int wv) {
    for (int t = bx * 512 + otid(wv); t < 131072; t += G * 512) {

    const int dg = t & 31, e = (t >> 5) & 255, chain = t >> 13;
    const int dirh = chain & 7, dir = dirh >> 2;
    float C[8], m = sM[chain];
#pragma unroll
    for (int j = 0; j < 8; ++j) C[j] = sC[(size_t)chain * 65536 + (size_t)(dg * 8 + j) * 256 + e];
    for (int i = 0; i < 16; ++i) {
        const int c = dir ? 15 - i : i; const size_t so = ((size_t)(chain * 16 + c) * 256 + e) * 256 + dg * 8;
        if (dg == 0 && e == 0) CH[CH_MC + chain * 16 + c] = m;
        pg8::u32x4 w; w.x = pg8::cvt_pk_bf16(C[0], C[1]); w.y = pg8::cvt_pk_bf16(C[2], C[3]); w.z = pg8::cvt_pk_bf16(C[4], C[5]); w.w = pg8::cvt_pk_bf16(C[6], C[7]);
        *(pg8::u32x4*)(CT + so) = w;
        if (i == 15) break;
        const float Mx = fmaxf(m, CH[CH_A + chain * 16 + c]), al = expf(m - Mx), be = expf(CH[CH_A + chain * 16 + c] - Mx); m = CH[CH_F + chain * 16 + c] + Mx;
        const pg8::u32x4 u = *(const pg8::u32x4*)(UT + so);
        const float uf[8] = {__uint_as_float(u.x << 16), __uint_as_float(u.x & 0xffff0000u), __uint_as_float(u.y << 16), __uint_as_float(u.y & 0xffff0000u),
                             __uint_as_float(u.z << 16), __uint_as_float(u.z & 0xffff0000u), __uint_as_float(u.w << 16), __uint_as_float(u.w & 0xffff0000u)};
#pragma unroll
        for (int j = 0; j < 8; ++j) C[j] = al * C[j] + be * uf[j];
    }
    if (t < 16 * 256) {
        const int ch2 = t >> 8, d = t & 255, dir2 = (ch2 & 7) >> 2; float n = sN[(size_t)ch2 * 256 + d], m2 = sM[ch2];
        for (int i = 0; i < 16; ++i) { const int c = dir2 ? 15 - i : i; NT[(size_t)(ch2 * 16 + c) * 256 + d] = n; if (i == 15) break;
            const float A2 = CH[CH_A + ch2 * 16 + c], Mx2 = fmaxf(m2, A2); n = expf(m2 - Mx2) * n + expf(A2 - Mx2) * UN[(size_t)(ch2 * 16 + c) * 256 + d]; m2 = CH[CH_F + ch2 * 16 + c] + Mx2; }
    }
    }
}
__device__ __forceinline__ void ph_qkpost(bf16_t* __restrict__ QA, bf16_t* __restrict__ KA, const float* __restrict__ q_g, const float* __restrict__ k_g, float* __restrict__ ck_out, unsigned char* lds, int bx, int G, int wv) {
    const int tid_ = otid(wv), lane = tid_ & 63, l = lane & 15; float* tab = (float*)lds;
    for (int i = tid_; i < 2048; i += 512) { const int pos = i >> 5, f = i & 31; const float ang = (float)pos * powf(10000.f, -(float)f / 32.f); tab[2 * i] = cosf(ang); tab[2 * i + 1] = sinf(ang); }
    __syncthreads();
    const int axis = l >> 3, half = (l >> 2) & 1, f0 = 8 * (l & 3);
    for (int it = bx * 8 + (tid_ >> 6); it < MTOK * 10 / 4; it += G * 8) {
        const int ht = it * 4 + (lane >> 4), row = ht / 10, hh = ht % 10, is_k = hh >= 8, head = is_k ? hh - 8 : hh;
        const int b = row < NCTX ? 0 : (row - NCTX) >> 12, tt = (row - NCTX) & 4095;
        bf16_t* xp = is_k ? KA + (size_t)(row < NCTX ? row : NCTX + b * KV_ROWS_LAT + tt) * 256 + head * 128 + 8 * l : QA + (size_t)row * 1024 + head * 128 + 8 * l;
        const float* gp = (is_k ? k_g : q_g) + 8 * l;
        const pg8::u32x4 raw = *(const pg8::u32x4*)xp;
        float x[8] = {__uint_as_float(raw.x << 16), __uint_as_float(raw.x & 0xffff0000u), __uint_as_float(raw.y << 16), __uint_as_float(raw.y & 0xffff0000u),
                      __uint_as_float(raw.z << 16), __uint_as_float(raw.z & 0xffff0000u), __uint_as_float(raw.w << 16), __uint_as_float(raw.w & 0xffff0000u)};
        float ss = 0.f;
#pragma unroll
        for (int j = 0; j < 8; ++j) ss += x[j] * x[j];
        ss += shx(ss, 1, lane); ss += shx(ss, 2, lane); ss += shx(ss, 4, lane); ss += shx(ss, 8, lane);
        const float r = 1.f / sqrtf(ss * (1.f / 128.f) + EPS);
        const f32x4 g0 = *(const f32x4*)gp, g1 = *(const f32x4*)(gp + 4);
#pragma unroll
        for (int j = 0; j < 4; ++j) { x[j] *= r * g0[j]; x[4 + j] *= r * g1[j]; }
        if (row < NCTX) {
            if (is_k) { float* cp = ck_out + (size_t)row * 256 + head * 128 + 8 * l; *(f32x4*)cp = (f32x4){x[0], x[1], x[2], x[3]}; *(f32x4*)(cp + 4) = (f32x4){x[4], x[5], x[6], x[7]}; }
        } else {
            const int pos = axis == 0 ? (tt >> 6) : (tt & 63); const float* tp = tab + (pos * 32 + f0) * 2;
#pragma unroll
            for (int j = 0; j < 8; ++j) { const float xo = shx(x[j], 4, lane), cs = tp[2 * j], sn = tp[2 * j + 1]; x[j] = half ? x[j] * cs + xo * sn : x[j] * cs - xo * sn; }
        }
        pg8::u32x4 o; o.x = pg8::cvt_pk_bf16(x[0], x[1]); o.y = pg8::cvt_pk_bf16(x[2], x[3]); o.z = pg8::cvt_pk_bf16(x[4], x[5]); o.w = pg8::cvt_pk_bf16(x[6], x[7]);
        *(pg8::u32x4*)xp = o;
    }
    __syncthreads();
}
__device__ __forceinline__ void ph_ln(float* __restrict__ V, const float* __restrict__ g, const float* __restrict__ bta, const float* __restrict__ mod, bf16_t* __restrict__ H2, int bx, int G, int wv) {
    const int tid_ = otid(wv), lane = tid_ & 63;
    for (int row = bx * 8 + (tid_ >> 6); row < MTOK; row += G * 8) {
        float* v = V + (size_t)row * DM + 4 * lane; f32x4 x[4]; float s = 0.f;
#pragma unroll
        for (int j = 0; j < 4; ++j) { x[j] = *(const f32x4*)(v + 256 * j); s += (x[j][0] + x[j][1]) + (x[j][2] + x[j][3]); }
        const float mean = wave_sum(s, lane) * (1.f / DM); float q = 0.f;
#pragma unroll
        for (int j = 0; j < 4; ++j) { x[j] = x[j] - mean; q += (x[j][0] * x[j][0] + x[j][1] * x[j][1]) + (x[j][2] * x[j][2] + x[j][3] * x[j][3]); }
        const float rstd = 1.f / sqrtf(wave_sum(q, lane) * (1.f / DM) + EPS);
        const float* md = mod + mod_index(row) * 6144 + 4 * lane;
#pragma unroll
        for (int j = 0; j < 4; ++j) { const int c = 4 * lane + 256 * j; const f32x4 y = x[j] * rstd * *(const f32x4*)(g + c) + *(const f32x4*)(bta + c); *(f32x4*)(v + 256 * j) = y;
            if (H2) { const f32x4 hv = y * (*(const f32x4*)(md + 4096 + 256 * j) + 1.f) + *(const f32x4*)(md + 3072 + 256 * j);
                pg8::u32x2 pk; pk.x = pg8::cvt_pk_bf16(hv[0], hv[1]); pk.y = pg8::cvt_pk_bf16(hv[2], hv[3]); *(pg8::u32x2*)(H2 + (size_t)row * DM + c) = pk; } }
    }
}
#define LAS __attribute__((address_space(3)))
#define XB_TMO      128
#define XB_XCNT(j)  (256  + 64 * (j))
#define XB_XSUB(j)  (1280 + 64 * (j))
#define XB_XGEN(j)  (2304 + 64 * (j))
#define XB_TOP      3328
#define XB_TOPGEN   3392
#define XCD_BAR_WORDS 3456
#define XB_SPIN_CAP (1u << 18)

__device__ __forceinline__ unsigned xb_ld(unsigned* p)              { return __hip_atomic_load(p, __ATOMIC_RELAXED, __HIP_MEMORY_SCOPE_AGENT); }
__device__ __forceinline__ unsigned xb_add(unsigned* p, unsigned v) { return __hip_atomic_fetch_add(p, v, __ATOMIC_RELAXED, __HIP_MEMORY_SCOPE_AGENT); }
__device__ __forceinline__ unsigned xb_xcc_id() { return (unsigned)__builtin_amdgcn_s_getreg((3 << 11) | 20) & 0xFu; }
#define XB_SPIN(cond, bar) do { unsigned _sp = 0; while (cond) { __builtin_amdgcn_s_sleep(1); \
    if ((++_sp & 255u) == 0u) { if (xb_ld(&(bar)[XB_TMO])) break; if (_sp > XB_SPIN_CAP) { atomicAdd(&(bar)[XB_TMO], 1u); break; } } } } while (0)

struct XcdBarrier {
    unsigned* bar; unsigned x;
    volatile LAS unsigned* st;
};

__device__ __forceinline__ XcdBarrier xcd_barrier_post(unsigned* bar, volatile LAS unsigned* st, bool leader) {
    XcdBarrier b; b.bar = bar; b.x = xb_xcc_id(); b.st = st;
    if (leader) (void)xb_add(&bar[XB_XCNT(b.x)], 1u);
    return b;
}
__device__ __forceinline__ void xcd_barrier_complete(unsigned* bar, unsigned x, unsigned& nloc, unsigned& nx) {
    const unsigned G = gridDim.x * gridDim.y * gridDim.z;
    unsigned sum, cnt, mine, sp = 0u;
    for (;;) {
        sum = 0u; cnt = 0u; mine = 0u;
#pragma unroll
        for (unsigned j = 0; j < 16; ++j) { const unsigned c = xb_ld(&bar[XB_XCNT(j)]); sum += c; cnt += (c > 0u) ? 1u : 0u; mine = (j == x) ? c : mine; }
        if (sum == G) break;
        __builtin_amdgcn_s_sleep(1);
        if ((++sp & 255u) == 0u) { if (xb_ld(&bar[XB_TMO])) break; if (sp > XB_SPIN_CAP) { atomicAdd(&bar[XB_TMO], 1u); break; } }
    }
    nloc = mine > 0u ? mine : 1u; nx = cnt > 0u ? cnt : 1u;
}

__device__ __forceinline__ void xcd_barrier(const XcdBarrier& b, int wv) {
    const bool leader_ = (wv == 0) && (__builtin_amdgcn_mbcnt_hi(~0u, __builtin_amdgcn_mbcnt_lo(~0u, 0u)) == 0u);
    asm volatile("s_waitcnt vmcnt(0)" ::: "memory");
    __syncthreads();
    if (leader_) {
        unsigned* bar = b.bar;
        __builtin_amdgcn_s_waitcnt(0);
        unsigned nloc = b.st[0], nx = b.st[1];
        if (nloc == 0u) { xcd_barrier_complete(bar, b.x, nloc, nx); b.st[0] = nloc; b.st[1] = nx; }
        const unsigned old = xb_add(&bar[XB_XSUB(b.x)], 1u);
        const unsigned gen = old / nloc;
        if (old + 1u == (gen + 1u) * nloc) {
            __builtin_amdgcn_fence(__ATOMIC_RELEASE, "agent");
            asm volatile("s_waitcnt vmcnt(0)" ::: "memory");
            const unsigned og = xb_add(&bar[XB_TOP], 1u);
            const unsigned tg = og / nx;
            if (og + 1u == (tg + 1u) * nx) xb_add(&bar[XB_TOPGEN], 1u);
            else XB_SPIN(xb_ld(&bar[XB_TOPGEN]) == tg, bar);
            __builtin_amdgcn_fence(__ATOMIC_ACQUIRE, "agent");
            xb_add(&bar[XB_XGEN(b.x)], 1u);
            asm volatile("s_waitcnt vmcnt(0)" ::: "memory");
        } else {
            XB_SPIN(xb_ld(&bar[XB_XGEN(b.x)]) == gen, bar);
            __builtin_amdgcn_fence(__ATOMIC_ACQUIRE, "agent");
            asm volatile("s_waitcnt vmcnt(0)" ::: "memory");
        }
    }
    __syncthreads();
}


constexpr int FG_LDS = 147456, MISC_OFF = 147200;
constexpr size_t WS_CTL = 768 * 1024, CTL_BYTES = 64 * 1024;
#ifndef REP_P0
#define REP_P0 1
#endif
#ifndef REP_HG
#define REP_HG 1
#endif
#ifndef REP_SCAN
#define REP_SCAN 1
#endif
#ifndef REP_P1A
#define REP_P1A 1
#endif
#ifndef REP_P1B
#define REP_P1B 1
#endif
#ifndef REP_U
#define REP_U 1
#endif
#ifndef REP_CS
#define REP_CS 1
#endif
#ifndef REP_AT
#define REP_AT 1
#endif
#ifndef REP_HU
#define REP_HU 1
#endif
#ifndef REP_P3A
#define REP_P3A 1
#endif
#ifndef REP_P3B
#define REP_P3B 1
#endif
#ifndef REP_UP
#define REP_UP 1
#endif
#ifndef REP_DN
#define REP_DN 1
#endif
#ifndef REP_BAR
#define REP_BAR 1
#endif
static_assert(REP_AT == 1 && REP_HU == 1, "the attention / h-unit repeat probes used the d_out y region as dummy output; it now holds GM | GA during the mixer phase");
#ifndef LEAK_A
#define LEAK_A 0
#endif
#ifndef LEAK_B
#define LEAK_B 0
#endif
#ifndef LEAK_SEL
#define LEAK_SEL 0
#endif
typedef const P __attribute__((address_space(4)))* KP;
__device__ __forceinline__ KP kargs() { KP k = (KP)__builtin_amdgcn_kernarg_segment_ptr(); asm volatile("" : "+s"(k)); return k; }
__global__ void __launch_bounds__(512, 2) k_mega(P p_unused) {
    extern __shared__ __attribute__((aligned(16))) unsigned char lds[];
    const int G = gridDim.x, bx = blockIdx.x, vcu = (G % 8 == 0) ? (bx % 8) * (G / 8) + bx / 8 : bx;
    volatile LAS unsigned* MISC = (volatile LAS unsigned*)((LAS unsigned char*)lds + MISC_OFF);
    const int wv = __builtin_amdgcn_readfirstlane(threadIdx.x >> 6);
    if (threadIdx.x < 64) MISC[threadIdx.x] = 0u;
    const bool leader0 = threadIdx.x == 0;
    __syncthreads();
    XcdBarrier bar = xcd_barrier_post((unsigned*)(kargs()->ws + WS_CTL), MISC + 8, leader0);
    PG8_LAS unsigned char* glds = (PG8_LAS unsigned char*)lds;
    int n_ts = 0;
#define TS() do { if (LEAK_B > LEAK_A) { if (bx == 0 && wv == 0 && (n_ts == LEAK_A || n_ts == LEAK_B)) { const unsigned long long t_ = __builtin_amdgcn_s_memrealtime(); if (otid(wv) == 0) ((volatile LAS unsigned long long*)(MISC + 16))[n_ts == LEAK_B] = t_; } ++n_ts; } } while (0)
    TS();
#define WSP(T, off) ((T*)(ws + (off)))
#define GEMM_PHASE(EPI, A_, lda_, Bt_, ldb_, M_, N_, K_, ...) do { pg8::Gemm g_{A_, Bt_, M_, N_, K_, lda_, ldb_, 0}; pg8::StaticOrder S_; S_.init(M_, N_, G, bx, lda_, ldb_); \
        pg8::gemm_phase<EPI, pg8::StaticOrder, true, true>(glds, g_, S_, EPI{__VA_ARGS__}, wv); } while (0)
    for (int rep_ = 0; rep_ < REP_P0; ++rep_) {
    { KP k = kargs(); unsigned char* ws = k->ws;
      ph_mod(k->c, k->c_ctx, k->w_mod, k->b_mod, WSP(float, WS_MOD), lds, bx, G, wv);
      ph_cache(k->cache_k, k->cache_v, WSP(bf16_t, WS_KA), WSP(bf16_t, WS_VA), bx, G, wv);
      ph_weights(k->w_in, k->w_bm, k->w_ba, k->w_out, k->w_up, k->w_down, ws, lds, bx, G, wv); }
    }
    xcd_barrier(bar, wv); TS();
    for (int rep_ = 0; rep_ < REP_HG; ++rep_) {
    { KP k = kargs(); unsigned char* ws = k->ws; ph_hgates(k->x_prompt, k->x_sample, k->w_in, k->b_gates, WSP(float, WS_MOD), WSP(bf16_t, WS_HB), WSP(float, WS_GATES), lds, bx, G, wv); }
    }
    xcd_barrier(bar, wv); TS();
    for (int rep_ = 0; rep_ < REP_SCAN; ++rep_) {
    { KP k = kargs(); unsigned char* ws = k->ws; ph_scan(WSP(float, WS_GATES), WSP(float, WS_SC), WSP(float, WS_CH), k->out + O_SM, bx, G, wv); }
    }
    xcd_barrier(bar, wv); TS();
    for (int rep_ = 0; rep_ < REP_P1A; ++rep_) { KP k = kargs(); unsigned char* ws = k->ws;
      pg8::Gemm g_{(const bf16_t*)ws, (const bf16_t*)ws, MTOK, 4608, DM, DM, DM, 0}; pg8::P1Order S_; S_.init(G, bx);
      pg8::gemm_phase<pg8::EpiP1, pg8::P1Order, true, true>(glds, g_, S_, pg8::EpiP1{
          pg8::EpiProj{WSP(bf16_t, WS_QM), WSP(bf16_t, WS_OM), WSP(bf16_t, WS_QA), WSP(bf16_t, WS_KA), WSP(bf16_t, WS_VA), WSP(bf16_t, WS_KM), WSP(bf16_t, WS_KM), WSP(bf16_t, WS_OM), k->out + O_CV, 0, 0},
          pg8::EpiKVT{WSP(bf16_t, WS_KFT), WSP(bf16_t, WS_VT), WSP(float, WS_SC) + SC_WU * SC_STRIDE}}, wv); }
    xcd_barrier(bar, wv); TS();
    { KP k = kargs(); unsigned char* ws = k->ws; ph_qkpost(WSP(bf16_t, WS_QA), WSP(bf16_t, WS_KA), k->q_g, k->k_g, k->out + O_CK, lds, bx, G, wv); }
    for (int rep_ = 0; rep_ < REP_U; ++rep_) {
    { KP k = kargs(); unsigned char* ws = k->ws; ph_un(WSP(bf16_t, WS_KFT), WSP(float, WS_CH), k->out + O_SN, WSP(float, WS_UN), bx, G, wv); }
    { KP k = kargs(); unsigned char* ws = k->ws; pg8::Gemm g0{WSP(bf16_t, WS_KFT), WSP(bf16_t, WS_VT), 256, 256, 256, MTOK, MTOK, 0}; pg8::UOrder S0; S0.init(G, bx, 0);
      pg8::gemm_phase<pg8::EpiUctx, pg8::UOrder, false, true>(glds, g0, S0, pg8::EpiUctx{k->out + O_SC, WSP(float, WS_CH) + CH_BETAC}, wv); }
    { KP k = kargs(); unsigned char* ws = k->ws; pg8::Gemm g1{WSP(bf16_t, WS_VT), WSP(bf16_t, WS_KFT), 256, 256, 256, MTOK, MTOK, 0}; pg8::UOrder S1; S1.init(G, G - 1 - bx, 1);
      pg8::gemm_phase<pg8::EpiUlat, pg8::UOrder, false, true>(glds, g1, S1, pg8::EpiUlat{(bf16_t*)(k->out + O_Y)}, wv); }
    }
    xcd_barrier(bar, wv); TS();
    for (int rep_ = 0; rep_ < REP_CS; ++rep_) {
    { KP k = kargs(); unsigned char* ws = k->ws; ph_cscan(k->state_C, k->state_n, k->state_m, (const bf16_t*)(k->out + O_Y), WSP(float, WS_UN), WSP(float, WS_CH), WSP(bf16_t, WS_KFT), WSP(float, WS_NT), bx, G, wv); }
    }
    xcd_barrier(bar, wv); TS();
    unsigned long long tmx0 = 0; if (LEAK_SEL) tmx0 = __builtin_amdgcn_s_memrealtime();
#define MIXSTAMP(slot) do { if (LEAK_SEL) { __syncthreads(); if (wv == 0 && otid(wv) == 0) { const unsigned dt_ = (unsigned)(__builtin_amdgcn_s_memrealtime() - tmx0); unsigned* cw_ = (unsigned*)(kargs()->ws + WS_CTL) + 8192; atomicMax(cw_ + 2 * (slot), dt_); atomicMax(cw_ + 2 * (slot) + 1, 0xffffffffu - dt_); } } } while (0)
    for (int rep_ = 0; rep_ < REP_AT; ++rep_) { KP k = kargs(); unsigned char* ws = k->ws; attn_phase(WSP(bf16_t, WS_QA), WSP(bf16_t, WS_KA), WSP(bf16_t, WS_VA), rep_ == REP_AT - 1 ? WSP(bf16_t, WS_QA) : (bf16_t*)(k->out + O_Y), (char*)lds, vcu, G, wv); }
    MIXSTAMP(0);
    { KP k = kargs(); unsigned char* ws = k->ws;
      for (int u = vcu; u < 384; u += G) { hu::hunit(u, ws, k->mlstm_g, lds, wv); __syncthreads(); } }
    MIXSTAMP(1);
    { KP k = kargs(); unsigned char* ws = k->ws; pg8::Gemm g_{WSP(bf16_t, WS_HB), WSP(bf16_t, WS_WIN) + (size_t)R_GM * DM, MTOK, 2048, DM, DM, DM, 0}; pg8::SigOrder S_; S_.init(G, vcu);
      pg8::gemm_phase<pg8::EpiSig2, pg8::SigOrder, true, true>(glds, g_, S_, pg8::EpiSig2{(bf16_t*)(k->out + O_Y), (bf16_t*)(k->out + O_Y) + (size_t)MTOK * DM}, wv); }
    MIXSTAMP(2);
    xcd_barrier(bar, wv); TS();
    for (int rep_ = 0; rep_ < REP_P3A; ++rep_) {
    { KP k = kargs(); unsigned char* ws = k->ws; GEMM_PHASE(pg8::EpiStoreF32, WSP(bf16_t, WS_QM), DM, WSP(bf16_t, WS_WBM), DM, MTOK, DM, DM, WSP(float, WS_KFT), DM, 0); }
    }
    xcd_barrier(bar, wv); TS();
    for (int rep_ = 0; rep_ < REP_P3B; ++rep_)
    { KP k = kargs(); unsigned char* ws = k->ws; GEMM_PHASE(pg8::EpiMergeF, WSP(bf16_t, WS_QA), DM, WSP(bf16_t, WS_WBA), DM, MTOK, DM, DM, WSP(float, WS_KFT), (const bf16_t*)(k->out + O_Y), (const bf16_t*)(k->out + O_Y) + (size_t)MTOK * DM, WSP(bf16_t, WS_VT)); }
    xcd_barrier(bar, wv); TS();
    for (int rep_ = 0; rep_ < REP_P3B; ++rep_)
    { KP k = kargs(); unsigned char* ws = k->ws; GEMM_PHASE(pg8::EpiResidXF, WSP(bf16_t, WS_VT), DM, WSP(bf16_t, WS_WOUT), DM, MTOK, DM, DM, k->x_prompt, k->x_sample, WSP(float, WS_MOD), k->out + O_Y, 2048, 0); }
    xcd_barrier(bar, wv); TS();
    { KP k = kargs(); unsigned char* ws = k->ws; ph_ln(k->out + O_Y, k->ln1_g, k->ln1_b, WSP(float, WS_MOD), WSP(bf16_t, WS_HB), bx, G, wv); }
    xcd_barrier(bar, wv); TS();
    for (int rep_ = 0; rep_ < REP_UP; ++rep_)
    { KP k = kargs(); unsigned char* ws = k->ws; GEMM_PHASE(pg8::EpiRelu2F, WSP(bf16_t, WS_HB), DM, WSP(bf16_t, WS_WUP), DM, MTOK, DFF, DM, WSP(bf16_t, WS_KM), DFF, 0); }
    xcd_barrier(bar, wv); TS();
    for (int rep_ = 1; rep_ < REP_DN; ++rep_)
    { KP k = kargs(); unsigned char* ws = k->ws; GEMM_PHASE(pg8::EpiStoreF32, WSP(bf16_t, WS_KM), DFF, WSP(bf16_t, WS_WDN), DFF, MTOK, DM, DFF, WSP(float, WS_QM), DM, 0); }
    { KP k = kargs(); unsigned char* ws = k->ws; GEMM_PHASE(pg8::EpiResidInF, WSP(bf16_t, WS_KM), DFF, WSP(bf16_t, WS_WDN), DFF, MTOK, DM, DFF, WSP(float, WS_MOD), k->out + O_Y, 5120, 0); }
    xcd_barrier(bar, wv); TS();
    { KP k = kargs(); unsigned char* ws = k->ws; ph_ln(k->out + O_Y, k->ln2_g, k->ln2_b, WSP(float, WS_MOD), (bf16_t*)nullptr, bx, G, wv); }
    for (int rep_ = 1; rep_ < REP_BAR; ++rep_) xcd_barrier(bar, wv);
    TS();
    if (LEAK_B > LEAK_A || LEAK_SEL) { if (LEAK_SEL) xcd_barrier(bar, wv); if (bx == 0) { __syncthreads(); const volatile LAS unsigned long long* tsv = (const volatile LAS unsigned long long*)(MISC + 16);
        float dt_us = (float)(tsv[1] - tsv[0]) * 0.01f;
        if (LEAK_SEL) { const unsigned* cw_ = (const unsigned*)(kargs()->ws + WS_CTL) + 8192; const unsigned v_ = __hip_atomic_load(cw_ + (LEAK_SEL - 1), __ATOMIC_RELAXED, __HIP_MEMORY_SCOPE_AGENT); dt_us = (float)(((LEAK_SEL - 1) & 1) ? 0xffffffffu - v_ : v_) * 0.01f; } const int t = otid(wv); if (t < 128) { float* om = kargs()->out + O_SM; om[t] = om[t] * (1.f + dt_us * 0.001f); } } }
}

extern "C" void kernel_launch(void* const* d_in, const int* in_sizes, int n_in, void* d_out, int out_size, void* d_ws, size_t ws_size, hipStream_t stream) {
    static int grid = 0;
    if (grid == 0) {
        int dev = 0, cus = 0, per_cu = 0;
        (void)hipGetDevice(&dev); (void)hipDeviceGetAttribute(&cus, hipDeviceAttributeMultiprocessorCount, dev);
        if (hipFuncSetAttribute((const void*)k_mega, hipFuncAttributeMaxDynamicSharedMemorySize, FG_LDS) != hipSuccess) fprintf(stderr, "kernel_launch: hipFuncSetAttribute failed\n");
        if (hipOccupancyMaxActiveBlocksPerMultiprocessor(&per_cu, (const void*)k_mega, 512, FG_LDS) != hipSuccess || per_cu < 1) { fprintf(stderr, "kernel_launch: occupancy query says %d blocks per CU\n", per_cu); per_cu = 1; }
        (void)hipGetLastError();
        grid = cus > 0 ? cus : 256;
    }
    (void)hipMemsetAsync((unsigned char*)d_ws + WS_CTL, 0, CTL_BYTES, stream);
    P p{};
    const float** pf = (const float**)&p;
    for (int i = 0; i < 25; ++i) pf[i] = (const float*)d_in[i];
    p.out = (float*)d_out; p.ws = (unsigned char*)d_ws;
    void* args[] = {&p};
    hipError_t e = hipLaunchCooperativeKernel((const void*)k_mega, dim3(grid), dim3(512), args, FG_LDS, stream);
    if (e != hipSuccess) fprintf(stderr, "kernel_launch: cooperative launch failed: %s (grid %d)\n", hipGetErrorString(e), grid);
}
```
